# Optimizing an MI355X kernel written in HIP

```python
import math
import jax
import jax.numpy as jnp
from jax import lax
import numpy as np

D_MODEL = 1024
BATCH = 16
SEQ = 256
DEPTH = 2
DEC_BATCH = 2
DEC_SEQ = 2048
PAST_LEN = 256

GRID_W = 64
HEAD_DIM = 64
D_MIX = D_MODEL
D_RG = 3 * D_MODEL // 4
RG_BLOCK = 64
RG_HEADS = D_RG // RG_BLOCK
RG_C = 8.0
CONV_W = 4
D_FNET = D_MIX - D_RG
FNET_GROUP_DIM = 64
FNET_GROUPS = D_FNET // FNET_GROUP_DIM
SWA_HEADS = (D_MIX // 2) // HEAD_DIM
SWA_KV_HEADS = SWA_HEADS // 4
GQA_GROUP = SWA_HEADS // SWA_KV_HEADS
WINDOW = 128
QBLOCK = 128
DIFF_HEADS = (D_MIX // 2) // (2 * HEAD_DIM)
DIFF_V_DIM = 2 * HEAD_DIM
N_EXPERTS = 16
EC_FACTOR = 2
D_EXPERT = 2 * D_MODEL
ROPE_BASE = 10000.0
LN_EPS = 1e-5
NEG_INF = -1e30
ATTN_SCALE = HEAD_DIM ** -0.5
N_EVEN = (DEPTH + 1) // 2
N_ODD = DEPTH // 2
ALPHA = (2 * DEPTH) ** 0.25
BETA = (8 * DEPTH) ** -0.25
EVEN_IN = 2 * D_RG + D_FNET
ODD_SIZES = (SWA_HEADS * HEAD_DIM, SWA_KV_HEADS * HEAD_DIM, SWA_KV_HEADS * HEAD_DIM,
             DIFF_HEADS * 2 * HEAD_DIM, DIFF_HEADS * 2 * HEAD_DIM, DIFF_HEADS * DIFF_V_DIM)
ODD_IN = sum(ODD_SIZES)
F32 = jnp.float32

kernel_name = 'hybrid_diffusion_rglru_fnet_swa_diffattn_ec_step'


def _layernorm(x, g, b):
    xf = x.astype(F32)
    mu = jnp.mean(xf, -1, keepdims=True)
    var = jnp.mean(jnp.square(xf - mu), -1, keepdims=True)
    return ((xf - mu) * lax.rsqrt(var + LN_EPS) * g + b).astype(x.dtype)


def _modulation(cvec, w, b):
    m = jax.nn.silu(cvec) @ w + b
    return [t[:, None, :] for t in jnp.split(m, 6, axis=-1)]


def _axial_rope(x):
    S = x.shape[1]
    rows = S // GRID_W
    row = jnp.broadcast_to(jnp.arange(rows)[:, None], (rows, GRID_W)).reshape(-1).astype(F32)
    col = jnp.broadcast_to(jnp.arange(GRID_W)[None, :], (rows, GRID_W)).reshape(-1).astype(F32)
    half = HEAD_DIM // 2
    nf = half // 2
    inv = jnp.power(ROPE_BASE, -jnp.arange(nf, dtype=F32) / nf)
    shape = (1, S) + (1,) * (x.ndim - 3) + (nf,)
    xf = x.astype(F32)
    parts = []
    for pos, seg in ((row, xf[..., :half]), (col, xf[..., half:])):
        ang = (pos[:, None] * inv).reshape(shape)
        cos, sin = jnp.cos(ang), jnp.sin(ang)
        x1, x2 = seg[..., :nf], seg[..., nf:]
        parts += [x1 * cos - x2 * sin, x2 * cos + x1 * sin]
    return jnp.concatenate(parts, axis=-1).astype(x.dtype)


def _dwconv_centred(x, w, b):
    K = w.shape[0]
    left = (K - 1) // 2
    S = x.shape[1]
    xp = jnp.pad(x, ((0, 0), (left, K - 1 - left), (0, 0)))
    y = b
    for k in range(K):
        y = y + xp[:, k:k + S] * w[k]
    return y


def _linear_scan(a, b, h0, reverse):
    def combine(e1, e2):
        a1, b1 = e1
        a2, b2 = e2
        return a1 * a2, a2 * b1 + b2
    a_cum, b_cum = lax.associative_scan(combine, (a, b), reverse=reverse, axis=1)
    return a_cum * h0[:, None, :] + b_cum


def _rglru_bidir(xc, h0, w_r, b_r, w_i, b_i, lam):
    B, S, _ = xc.shape
    xf = xc.astype(F32)
    xh = xf.reshape(B, S, RG_HEADS, RG_BLOCK)

    def gate(w, bias):
        z = jnp.einsum('bshc,zhcd->zbshd', xh, w.astype(F32)).reshape(2, B, S, D_RG)
        return jax.nn.sigmoid(z + bias.astype(F32)[:, None, None, :])

    r = gate(w_r, b_r)
    i = gate(w_i, b_i)
    log_a = -RG_C * jax.nn.softplus(-lam.astype(F32))[:, None, None, :] * r
    a = jnp.exp(log_a)
    bt = jnp.sqrt(-jnp.expm1(2.0 * log_a)) * i * xf[None]
    h0f = h0.astype(F32)
    hf = _linear_scan(a[0], bt[0], h0f[:, 0], False)
    hb = _linear_scan(a[1], bt[1], h0f[:, 1], True)
    return hf, hb


def _fourier_mix(xf, w_f):
    B, S, _ = xf.shape
    z = xf.astype(F32).reshape(B, S, FNET_GROUPS, FNET_GROUP_DIM)
    f = jnp.fft.fft2(z, axes=(1, 3), norm='ortho').real
    y = jnp.einsum('bsgc,gcd->bsgd', f, w_f.astype(F32))
    return y.reshape(B, S, D_FNET).astype(xf.dtype)


def _even_mixer(u, h0, w_in, conv_w, conv_b, w_r, b_r, w_i, b_i, lam, w_f, w_out):
    proj = u @ w_in
    xa, ga, xfn = jnp.split(proj, [D_RG, 2 * D_RG], axis=-1)
    xc = _dwconv_centred(xa, conv_w, conv_b)
    hf, hb = _rglru_bidir(xc, h0, w_r, b_r, w_i, b_i, lam)
    y_rg = (hf + hb).astype(u.dtype) * jax.nn.gelu(ga)
    y_fn = _fourier_mix(xfn, w_f)
    out = jnp.concatenate([y_rg, y_fn], axis=-1) @ w_out
    final_state = jnp.stack([hf[:, -1], hb[:, 0]], axis=1)
    return out, final_state


def _odd_project(u, w_in):
    B, S, _ = u.shape
    cuts = np.cumsum(ODD_SIZES)[:-1].tolist()
    qs, ks, vs, qd, kd, vd = jnp.split(u @ w_in, cuts, axis=-1)
    return (qs.reshape(B, S, SWA_KV_HEADS, GQA_GROUP, HEAD_DIM),
            ks.reshape(B, S, SWA_KV_HEADS, HEAD_DIM),
            vs.reshape(B, S, SWA_KV_HEADS, HEAD_DIM),
            qd.reshape(B, S, DIFF_HEADS, 2, HEAD_DIM),
            kd.reshape(B, S, DIFF_HEADS, 2, HEAD_DIM),
            vd.reshape(B, S, DIFF_HEADS, DIFF_V_DIM))


def _map_qblocks(fn, q):
    B, S = q.shape[:2]
    nb = S // QBLOCK
    qb = jnp.moveaxis(q.reshape((B, nb, QBLOCK) + q.shape[2:]), 1, 0)
    out = lax.map(lambda args: fn(*args), (qb, jnp.arange(nb)))
    out = jnp.moveaxis(out, 0, 1)
    return out.reshape((B, S) + out.shape[3:])


def _sink_attend(qb, segs, sink):
    B, Q = qb.shape[:2]
    logits = []
    for k, _, mask in segs:
        s = jnp.einsum('bqhgd,bkhd->bhgqk', qb, k).astype(F32) * ATTN_SCALE
        if mask is not None:
            s = jnp.where(mask, s, NEG_INF)
        logits.append(s)
    sink_l = jnp.broadcast_to(sink.astype(F32)[None, :, :, None, None], (B, SWA_KV_HEADS, GQA_GROUP, Q, 1))
    w = jax.nn.softmax(jnp.concatenate([sink_l] + logits, axis=-1), axis=-1)
    out = 0.0
    off = 1
    for k, v, _ in segs:
        n = k.shape[1]
        out = out + jnp.einsum('bhgqk,bkhd->bqhgd', w[..., off:off + n].astype(v.dtype), v)
        off += n
    return out


def _swa_context(q, k, v, sink):
    return _map_qblocks(lambda qb, blk: _sink_attend(qb, [(k, v, None)], sink), q)


def _swa_latent(q, k, v, ck, cv, sink):
    S = q.shape[1]
    pad = ((0, 0), (WINDOW, WINDOW), (0, 0), (0, 0))
    kp, vp = jnp.pad(k, pad), jnp.pad(v, pad)
    span = QBLOCK + 2 * WINDOW

    def fn(qb, blk):
        start = blk * QBLOCK
        kw = lax.dynamic_slice_in_dim(kp, start, span, axis=1)
        vw = lax.dynamic_slice_in_dim(vp, start, span, axis=1)
        qpos = start + jnp.arange(QBLOCK)
        kpos = start - WINDOW + jnp.arange(span)
        mask = ((jnp.abs(qpos[:, None] - kpos[None, :]) <= WINDOW)
                & (kpos >= 0)[None, :] & (kpos < S)[None, :])
        return _sink_attend(qb, [(ck, cv, None), (kw, vw, mask)], sink)

    return _map_qblocks(fn, q)


def _diff_attend(q, k, v, lam):
    def fn(qb, blk):
        s = jnp.einsum('bqhmd,bkhmd->bhmqk', qb, k).astype(F32) * ATTN_SCALE
        a = jax.nn.softmax(s, axis=-1)
        w = a[:, :, 0] - lam[None, :, None, None] * a[:, :, 1]
        return jnp.einsum('bhqk,bkhe->bqhe', w.astype(v.dtype), v)
    return _map_qblocks(fn, q)


def _lambda_init(layer):
    return 0.8 - 0.6 * math.exp(-0.3 * layer)


def _diff_lambda(lam_p, lam_init):
    lp = lam_p.astype(F32)
    return jnp.exp(jnp.sum(lp[0] * lp[1], -1)) - jnp.exp(jnp.sum(lp[2] * lp[3], -1)) + lam_init


def _odd_merge(u, ys, yd, subln_g, lam_init, w_out):
    B, S = u.shape[:2]
    ydf = yd.astype(F32)
    ydn = (ydf * lax.rsqrt(jnp.mean(jnp.square(ydf), -1, keepdims=True) + LN_EPS)
           * subln_g.astype(F32) * (1.0 - lam_init))
    mixed = jnp.concatenate([ys.reshape(B, S, -1), ydn.astype(u.dtype).reshape(B, S, -1)], axis=-1)
    return mixed @ w_out


def _odd_mixer_context(u, layer, w_in, sink, lam_p, subln_g, w_out):
    qs, ks, vs, qd, kd, vd = _odd_project(u, w_in)
    lam_init = _lambda_init(layer)
    ys = _swa_context(qs, ks, vs, sink.reshape(SWA_KV_HEADS, GQA_GROUP))
    yd = _diff_attend(qd, kd, vd, _diff_lambda(lam_p, lam_init))
    return _odd_merge(u, ys, yd, subln_g, lam_init, w_out), (ks, vs, kd, vd)


def _odd_mixer_latent(u, ctx_swa_k, ctx_swa_v, ctx_diff_k, ctx_diff_v, layer, w_in, sink, lam_p, subln_g, w_out):
    qs, ks, vs, qd, kd, vd = _odd_project(u, w_in)
    qs, ks, qd, kd = [_axial_rope(t) for t in (qs, ks, qd, kd)]
    lam_init = _lambda_init(layer)
    ys = _swa_latent(qs, ks, vs, ctx_swa_k, ctx_swa_v, sink.reshape(SWA_KV_HEADS, GQA_GROUP))
    k_all = jnp.concatenate([kd, ctx_diff_k], axis=1)
    v_all = jnp.concatenate([vd, ctx_diff_v], axis=1)
    yd = _diff_attend(qd, k_all, v_all, _diff_lambda(lam_p, lam_init))
    return _odd_merge(u, ys, yd, subln_g, lam_init, w_out)


def _expert_choice_ffn(u, w_router, w_gate, w_up, w_down):
    B, S, D = u.shape
    n = B * S
    cap = EC_FACTOR * n // N_EXPERTS
    tok = u.reshape(n, D)
    aff = jax.nn.softmax((tok @ w_router).astype(F32), axis=-1)
    g, idx = lax.top_k(aff.T, cap)
    xe = tok[idx]
    h = jax.nn.silu(jnp.einsum('ecd,edf->ecf', xe, w_gate)) * jnp.einsum('ecd,edf->ecf', xe, w_up)
    ye = jnp.einsum('ecf,efd->ecd', h, w_down) * g[..., None].astype(u.dtype)
    out = jnp.zeros_like(tok).at[idx.reshape(-1)].add(ye.reshape(-1, D).astype(tok.dtype))
    return out.reshape(B, S, D)


def setup_inputs(seed: int = 0) -> dict:
    key = jax.random.key(seed)
    keys = iter(jax.random.split(key, 40))

    def nrm(shape, scale):
        return jax.random.normal(next(keys), shape, F32) * scale

    a0 = jax.random.uniform(next(keys), (N_EVEN, 2, D_RG), F32, minval=0.9, maxval=0.999)
    r0 = a0 ** (1.0 / RG_C)
    e_lambda = jnp.log(r0) - jnp.log1p(-r0)
    return {
        'x_prompt': nrm((BATCH, SEQ, D_MODEL), 1.0),
        'x_sample': nrm((DEC_BATCH, DEC_SEQ, D_MODEL), 1.0),
        'state_rglru': nrm((DEC_BATCH, N_EVEN, 2, D_RG), 0.5),
        'cache_swa_k': nrm((DEC_BATCH, N_ODD, PAST_LEN, SWA_KV_HEADS, HEAD_DIM), 1.0),
        'cache_swa_v': nrm((DEC_BATCH, N_ODD, PAST_LEN, SWA_KV_HEADS, HEAD_DIM), 1.0),
        'cache_diff_k': nrm((DEC_BATCH, N_ODD, PAST_LEN, DIFF_HEADS, 2, HEAD_DIM), 1.0),
        'cache_diff_v': nrm((DEC_BATCH, N_ODD, PAST_LEN, DIFF_HEADS, DIFF_V_DIM), 1.0),
        'c': nrm((DEC_BATCH, D_MODEL), 1.0),
        'c_ctx': nrm((D_MODEL,), 1.0),
        'w_mod': nrm((DEPTH, D_MODEL, 6 * D_MODEL), 0.5 * D_MODEL ** -0.5),
        'b_mod': nrm((DEPTH, 6 * D_MODEL), 0.02),
        'ln_g': 1.0 + nrm((DEPTH, 2, D_MODEL), 0.02),
        'ln_b': nrm((DEPTH, 2, D_MODEL), 0.02),
        'e_w_in': nrm((N_EVEN, D_MODEL, EVEN_IN), D_MODEL ** -0.5),
        'e_conv_w': nrm((N_EVEN, CONV_W, D_RG), CONV_W ** -0.5),
        'e_conv_b': nrm((N_EVEN, D_RG), 0.02),
        'e_w_rgate': nrm((N_EVEN, 2, RG_HEADS, RG_BLOCK, RG_BLOCK), RG_BLOCK ** -0.5),
        'e_b_rgate': nrm((N_EVEN, 2, D_RG), 0.1),
        'e_w_igate': nrm((N_EVEN, 2, RG_HEADS, RG_BLOCK, RG_BLOCK), RG_BLOCK ** -0.5),
        'e_b_igate': nrm((N_EVEN, 2, D_RG), 0.1),
        'e_lambda': e_lambda,
        'e_w_fnet': nrm((N_EVEN, FNET_GROUPS, FNET_GROUP_DIM, FNET_GROUP_DIM), FNET_GROUP_DIM ** -0.5),
        'e_w_out': nrm((N_EVEN, D_MIX, D_MODEL), BETA * D_MIX ** -0.5),
        'o_w_in': nrm((N_ODD, D_MODEL, ODD_IN), D_MODEL ** -0.5),
        'o_sink': nrm((N_ODD, SWA_HEADS), 0.5),
        'o_lambda': nrm((N_ODD, 4, DIFF_HEADS, HEAD_DIM), 0.1),
        'o_subln_g': 1.0 + nrm((N_ODD, DIFF_V_DIM), 0.02),
        'o_w_out': nrm((N_ODD, D_MIX, D_MODEL), BETA * D_MIX ** -0.5),
        'w_router': nrm((DEPTH, D_MODEL, N_EXPERTS), D_MODEL ** -0.5),
        'w_gate': nrm((DEPTH, N_EXPERTS, D_MODEL, D_EXPERT), D_MODEL ** -0.5),
        'w_up': nrm((DEPTH, N_EXPERTS, D_MODEL, D_EXPERT), D_MODEL ** -0.5),
        'w_down': nrm((DEPTH, N_EXPERTS, D_EXPERT, D_MODEL), BETA * D_EXPERT ** -0.5),
    }


def reference(x_prompt, x_sample, state_rglru, cache_swa_k, cache_swa_v, cache_diff_k, cache_diff_v,
              c, c_ctx, w_mod, b_mod, ln_g, ln_b,
              e_w_in, e_conv_w, e_conv_b, e_w_rgate, e_b_rgate, e_w_igate, e_b_igate, e_lambda,
              e_w_fnet, e_w_out, o_w_in, o_sink, o_lambda, o_subln_g, o_w_out,
              w_router, w_gate, w_up, w_down):

    def run_layer(l, x, cvec, mix):
        sa, ca, ga, sf, cf, gf = _modulation(cvec, w_mod[l], b_mod[l])
        out, extra = mix(x * (1.0 + ca) + sa)
        x = _layernorm(ALPHA * x + ga * out, ln_g[l, 0], ln_b[l, 0])
        ffn = _expert_choice_ffn(x * (1.0 + cf) + sf, w_router[l], w_gate[l], w_up[l], w_down[l])
        x = _layernorm(ALPHA * x + gf * ffn, ln_g[l, 1], ln_b[l, 1])
        return x, extra

    def even_mix(j, u, h0):
        return _even_mixer(u, h0, e_w_in[j], e_conv_w[j], e_conv_b[j], e_w_rgate[j], e_b_rgate[j],
                           e_w_igate[j], e_b_igate[j], e_lambda[j], e_w_fnet[j], e_w_out[j])

    x = x_prompt
    cvec_ctx = c_ctx[None, :]
    rg_states, swa_k, swa_v, diff_k, diff_v = [], [], [], [], []
    for l in range(DEPTH):
        j = l // 2
        if l % 2 == 0:
            h0 = jnp.zeros((x.shape[0], 2, D_RG), F32)
            x, st = run_layer(l, x, cvec_ctx, lambda u, j=j, h0=h0: even_mix(j, u, h0))
            rg_states.append(st)
        else:
            x, (ks, vs, kd, vd) = run_layer(
                l, x, cvec_ctx,
                lambda u, j=j, l=l: _odd_mixer_context(u, l, o_w_in[j], o_sink[j], o_lambda[j],
                                                       o_subln_g[j], o_w_out[j]))
            swa_k.append(ks)
            swa_v.append(vs)
            diff_k.append(kd)
            diff_v.append(vd)
    y_prompt = x
    new_state_rglru = jnp.stack(rg_states, axis=1)
    new_cache_swa_k = jnp.stack(swa_k, axis=1)
    new_cache_swa_v = jnp.stack(swa_v, axis=1)
    new_cache_diff_k = jnp.stack(diff_k, axis=1)
    new_cache_diff_v = jnp.stack(diff_v, axis=1)

    x = x_sample
    for l in range(DEPTH):
        j = l // 2
        if l % 2 == 0:
            x, _ = run_layer(l, x, c, lambda u, j=j: even_mix(j, u, state_rglru[:, j]))
        else:
            x, _ = run_layer(
                l, x, c,
                lambda u, j=j, l=l: (_odd_mixer_latent(u, cache_swa_k[:, j], cache_swa_v[:, j],
                                                       cache_diff_k[:, j], cache_diff_v[:, j], l,
                                                       o_w_in[j], o_sink[j], o_lambda[j],
                                                       o_subln_g[j], o_w_out[j]), None))
    y_sample = x

    return (y_prompt, y_sample, new_state_rglru, new_cache_swa_k, new_cache_swa_v, new_cache_diff_k, new_cache_diff_v)
```

```cpp
#include <hip/hip_runtime.h>
#include <hip/hip_cooperative_groups.h>
#include <stdint.h>
#include <stdio.h>
#include <string.h>
namespace cg = cooperative_groups;

#ifndef GD4
#define GD4 1
#endif
#ifndef PROJ_MT
#define PROJ_MT 4
#endif
#ifndef MOE_MT
#define MOE_MT 8
#endif
#ifndef MOE_D
#define MOE_D 1
#endif
#ifndef MULTI_LAUNCH
#define MULTI_LAUNCH 0
#endif

typedef __attribute__((ext_vector_type(8))) short bf16x8;
typedef __attribute__((ext_vector_type(4))) float f32x4;
typedef unsigned short bf16_t;
typedef __attribute__((ext_vector_type(4))) unsigned int u32x4;

#define NTOK 8192
#define NCTX 4096
#define DM 1024
#define ALPHA_F 1.4142135623730951f
#define LAM_INIT 0.35550906759f

struct Params {
  const float *x_prompt, *x_sample, *state_rglru, *cache_swa_k, *cache_swa_v, *cache_diff_k, *cache_diff_v;
  const float *c, *c_ctx, *w_mod, *b_mod, *ln_g, *ln_b;
  const float *e_w_in, *e_conv_w, *e_conv_b, *e_w_rgate, *e_b_rgate, *e_w_igate, *e_b_igate, *e_lambda, *e_w_fnet, *e_w_out;
  const float *o_w_in, *o_sink, *o_lambda, *o_subln_g, *o_w_out;
  const float *w_router, *w_gate, *w_up, *w_down;
  float* out;
  unsigned* bar;
  unsigned* cnt;
  float* mod;
  bf16_t* wcsT;
  float* wrT;
  float* lam;
  bf16_t *cswaK, *cswaVt, *cdiffK, *cdiffVt;
  bf16_t* ubuf;
  float* proj0;
  float *sumA, *sumB;
  bf16_t* YT;
  float* yfn;
  bf16_t* mixed;
  float* pre;
  float* x1;
  bf16_t* tok;
  float* aff;
  int* idx;
  float* gsel;
  bf16_t* hbuf;
  float* ffn;
  float* ye;
  int* tcount;
  int* tlist;
  float* x2;
  bf16_t *swaQ, *swaK, *swaVt, *diffQ, *diffK, *diffVt;
};

__device__ __forceinline__ int tid() { int t = threadIdx.x; asm volatile("" : "+v"(t)); return t; }
typedef __attribute__((ext_vector_type(2))) float f32x2_t;
typedef __attribute__((ext_vector_type(2))) __bf16 bf16x2_t;
__device__ __forceinline__ uint32_t pack2(float a, float b) {
  f32x2_t v = {a, b};
  bf16x2_t r = __builtin_convertvector(v, bf16x2_t);
  return *(uint32_t*)&r;
}
__device__ __forceinline__ uint32_t f2bf(float f) { return pack2(f, 0.f) & 0xffffu; }
typedef __attribute__((ext_vector_type(2))) unsigned u32x2;
template <int CTRL>
__device__ __forceinline__ float dpp_add(float v) {
  int t = __builtin_amdgcn_update_dpp(0, __float_as_int(v), CTRL, 0xf, 0xf, false);
  return v + __int_as_float(t);
}
__device__ __forceinline__ float row_allsum(float v) {
  v = dpp_add<0x128>(v); v = dpp_add<0x124>(v); v = dpp_add<0x122>(v); v = dpp_add<0x121>(v);
  return v;
}
__device__ __forceinline__ float x16_sum(float v) { u32x2 r = __builtin_amdgcn_permlane16_swap(__float_as_uint(v), __float_as_uint(v), false, false); return __uint_as_float(r[0]) + __uint_as_float(r[1]); }
__device__ __forceinline__ float x32_sum(float v) { u32x2 r = __builtin_amdgcn_permlane32_swap(__float_as_uint(v), __float_as_uint(v), false, false); return __uint_as_float(r[0]) + __uint_as_float(r[1]); }
__device__ __forceinline__ float x16_max(float v) { u32x2 r = __builtin_amdgcn_permlane16_swap(__float_as_uint(v), __float_as_uint(v), false, false); return fmaxf(__uint_as_float(r[0]), __uint_as_float(r[1])); }
__device__ __forceinline__ float x32_max(float v) { u32x2 r = __builtin_amdgcn_permlane32_swap(__float_as_uint(v), __float_as_uint(v), false, false); return fmaxf(__uint_as_float(r[0]), __uint_as_float(r[1])); }
__device__ __forceinline__ float x32_partner(float v, bool hi) { u32x2 r = __builtin_amdgcn_permlane32_swap(__float_as_uint(v), __float_as_uint(v), false, false); return __uint_as_float(hi ? r[0] : r[1]); }
__device__ __forceinline__ float x16_partner(float v, bool odd) { u32x2 r = __builtin_amdgcn_permlane16_swap(__float_as_uint(v), __float_as_uint(v), false, false); return __uint_as_float(odd ? r[0] : r[1]); }
__device__ __forceinline__ float wave_sum(float v) { return x32_sum(x16_sum(row_allsum(v))); }
__device__ __forceinline__ void wave_sum2(float& a, float& b) {
  a = row_allsum(a); b = row_allsum(b);
  a = x16_sum(a); b = x16_sum(b);
  a = x32_sum(a); b = x32_sum(b);
}
__device__ __forceinline__ int wave_sum_i(int v) {
#pragma unroll
  for (int o = 32; o; o >>= 1) v += __shfl_xor(v, o);
  return v;
}
__device__ __forceinline__ float sigmoidf_(float x) { return __builtin_amdgcn_rcpf(1.0f + __expf(-x)); }
__device__ __forceinline__ float siluf_(float x) { return x * __builtin_amdgcn_rcpf(1.0f + __expf(-x)); }
__device__ __forceinline__ float gelu_tanh(float x) {
  float y = 0.7978845608028654f * (x + 0.044715f * x * x * x);
  float e = __expf(2.0f * y);
  float th = 1.0f - 2.0f * __builtin_amdgcn_rcpf(e + 1.0f);
  return 0.5f * x * (1.0f + th);
}
__device__ __forceinline__ int vec_of_token(int token) { return token < NCTX ? 0 : 1 + ((token - NCTX) >> 11); }

#define MFMA16(a, b, c) __builtin_amdgcn_mfma_f32_16x16x32_bf16((a), (b), (c), 0, 0, 0)

struct ADirect {
  const bf16_t* base; int lda;
  typedef uint32_t RowH;
  __device__ __forceinline__ RowH row(int r) const { return (uint32_t)r * (uint32_t)lda; }
  __device__ __forceinline__ u32x4 load(RowH h, int k) const { return *(const u32x4*)(base + h + k); }
};
struct AGather {
  const bf16_t* base; const int* idx; int lda;
  typedef uint32_t RowH;
  __device__ __forceinline__ RowH row(int r) const { return (uint32_t)idx[r] * (uint32_t)lda; }
  __device__ __forceinline__ u32x4 load(RowH h, int k) const { return *(const u32x4*)(base + h + k); }
};
struct ADft {
  int m0, S, smask; float invS; int koff;
  typedef int RowH;
  __device__ __forceinline__ RowH row(int r) const { return m0 + r; }
  __device__ __forceinline__ u32x4 load(RowH ks, int kk) const {
    const int k = kk + koff;
    const bool part = k >= S;
    const int s0 = part ? k - S : k;
    float v[8];
    int id = (ks * s0) & smask;
    if (part) {
#pragma unroll
      for (int i = 0; i < 8; ++i) { v[i] = -__builtin_amdgcn_sinf((float)id * invS); id = (id + ks) & smask; }
    } else {
#pragma unroll
      for (int i = 0; i < 8; ++i) { v[i] = __builtin_amdgcn_cosf((float)id * invS); id = (id + ks) & smask; }
    }
    u32x4 r;
    r.x = pack2(v[0], v[1]); r.y = pack2(v[2], v[3]); r.z = pack2(v[4], v[5]); r.w = pack2(v[6], v[7]);
    return r;
  }
};
struct AMixedFn {
  const bf16_t* mixed; const float* yfn;
  typedef uint32_t RowH;
  __device__ __forceinline__ RowH row(int r) const { return (uint32_t)r; }
  __device__ __forceinline__ u32x4 load(RowH h, int k) const {
    if (k < 768) return *(const u32x4*)(mixed + h * 1024u + k);
    const float* f = yfn + h * 256u + (k - 768);
    f32x4 a = *(const f32x4*)f, b = *(const f32x4*)(f + 4);
    u32x4 r;
    r.x = pack2(a[0], a[1]); r.y = pack2(a[2], a[3]); r.z = pack2(b[0], b[1]); r.w = pack2(b[2], b[3]);
    return r;
  }
};
struct BWeight {
  static constexpr bool kDirect = false;
  static constexpr bool kUniform = true;
  const float* base; int ldb;
  __device__ __forceinline__ const float* colptr(int n4) const { return base + n4; }
};
struct BGateUp {
  static constexpr bool kDirect = false;
  static constexpr bool kUniform = false;
  const float* wg; long long du; int ldb;
  __device__ __forceinline__ const float* colptr(int n4) const {
    int wn = n4 >> 6, within = n4 & 63;
    int col = wn * 32 + (within & 31);
    return (const float*)((const char*)wg + (long long)(within >> 5) * du) + col;
  }
};
struct BDirect {
  static constexpr bool kDirect = true;
  static constexpr bool kUniform = false;
  const bf16_t* base; int ldk;
  __device__ __forceinline__ const bf16_t* rowptr(int n) const { return base + (size_t)n * ldk; }
};

template <int MT, class AL, class BL>
struct GemmStage {
  u32x4 ra[MT];
  f32x4 rbw[8];
  u32x4 rbd[4];
};

template <int MT, class AL, class BL>
__device__ __forceinline__ void gemm_load(GemmStage<MT, AL, BL>& st, const AL& al, const BL& bl, const typename AL::RowH (&rh)[MT],
                                          const float* bp, const bf16_t* const (&bdp)[4], int kc, int k0) {
#pragma unroll
  for (int i = 0; i < MT; ++i) st.ra[i] = al.load(rh[i], k0 + kc * 8);
  if constexpr (!BL::kDirect && BL::kUniform) {
    const uint32_t boff = (uint32_t)(uintptr_t)bp;
#pragma unroll
    for (int j = 0; j < 8; ++j) {
      const float* rowb = bl.base + (size_t)(k0 + j) * bl.ldb;
      st.rbw[j] = *(const f32x4*)(rowb + boff);
    }
  } else if constexpr (!BL::kDirect) {
    const float* bq = bp + (size_t)k0 * bl.ldb;
#pragma unroll
    for (int j = 0; j < 8; ++j) st.rbw[j] = *(const f32x4*)(bq + (size_t)j * bl.ldb);
  } else {
#pragma unroll
    for (int i = 0; i < 4; ++i) st.rbd[i] = *(const u32x4*)(bdp[i] + k0);
  }
}

template <int MT, class AL, class BL>
__device__ __forceinline__ void gemm_store(const GemmStage<MT, AL, BL>& st, bf16_t* sA, bf16_t* sB, int t, int kc, int bg, int bkg) {
#pragma unroll
  for (int i = 0; i < MT; ++i) *(u32x4*)(sA + ((t >> 3) + 32 * i) * 64 + ((kc ^ ((t >> 4) & 7)) * 8)) = st.ra[i];
  if constexpr (!BL::kDirect) {
#pragma unroll
    for (int i = 0; i < 4; ++i) {
      const int n = 4 * bg + i;
      u32x4 v;
      v.x = pack2(st.rbw[0][i], st.rbw[1][i]);
      v.y = pack2(st.rbw[2][i], st.rbw[3][i]);
      v.z = pack2(st.rbw[4][i], st.rbw[5][i]);
      v.w = pack2(st.rbw[6][i], st.rbw[7][i]);
      *(u32x4*)(sB + n * 64 + ((bkg ^ ((n >> 1) & 7)) * 8)) = v;
    }
  } else {
#pragma unroll
    for (int i = 0; i < 4; ++i) {
      const int n = (t >> 3) + 32 * i;
      *(u32x4*)(sB + n * 64 + ((kc ^ ((n >> 1) & 7)) * 8)) = st.rbd[i];
    }
  }
}

template <int MT>
__device__ __forceinline__ void gemm_compute(f32x4 (&acc)[MT][4], const bf16_t* sA, const bf16_t* sB, int wm, int wn, int c, int q) {
  const bf16_t* pa = sA + (wm * MT * 16 + c) * 64;
  const bf16_t* pb = sB + (wn * 64 + c) * 64;
  __builtin_amdgcn_s_setprio(1);
#pragma unroll
  for (int ks = 0; ks < 2; ++ks) {
    const int ko = ((ks * 4 + q) ^ (c >> 1)) * 8;
    bf16x8 bfr[4];
    bf16x8 afr[3];
#pragma unroll
    for (int nt = 0; nt < 4; ++nt) bfr[nt] = *(const bf16x8*)(pb + nt * 16 * 64 + ko);
    afr[0] = *(const bf16x8*)(pa + ko);
    if (MT > 1) afr[1] = *(const bf16x8*)(pa + 1 * 16 * 64 + ko);
    __builtin_amdgcn_sched_group_barrier(0x100, 6, 0);
#pragma unroll
    for (int mt = 0; mt < MT; ++mt) {
      if (mt + 2 < MT) afr[(mt + 2) % 3] = *(const bf16x8*)(pa + (mt + 2) * 16 * 64 + ko);
#pragma unroll
      for (int nt = 0; nt < 4; ++nt) acc[mt][nt] = MFMA16(afr[mt % 3], bfr[nt], acc[mt][nt]);
      if (mt + 2 < MT) __builtin_amdgcn_sched_group_barrier(0x100, 1, 0);
      __builtin_amdgcn_sched_group_barrier(0x008, 4, 0);
    }
  }
  __builtin_amdgcn_s_setprio(0);
}

template <int MT, int DEPTH, bool NOLOAD = false, class AL, class BL, class EP>
__device__ __forceinline__ void gemm_tile(char* smem, int K, const AL al, const BL bl, const EP ep) {
  constexpr int BM = MT * 32;
  bf16_t* sA = (bf16_t*)smem;
  bf16_t* sB = sA + BM * 64;
  const int t = tid(), lane = t & 63, w = t >> 6, wm = w >> 1, wn = w & 1;
  const int c = lane & 15, q = lane >> 4;
  f32x4 acc[MT][4];
#pragma unroll
  for (int i = 0; i < MT; ++i)
#pragma unroll
    for (int j = 0; j < 4; ++j) acc[i][j] = f32x4{0.f, 0.f, 0.f, 0.f};

  typename AL::RowH rh[MT];
#pragma unroll
  for (int i = 0; i < MT; ++i) rh[i] = al.row((t >> 3) + 32 * i);
  const int kc = t & 7;
  const int bg = t & 31, bkg = t >> 5;
  const float* bp = nullptr;
  const bf16_t* bdp[4] = {nullptr, nullptr, nullptr, nullptr};
  if constexpr (!BL::kDirect && BL::kUniform) {
    bp = (const float*)(uintptr_t)(uint32_t)(4 * bg + bkg * 8 * bl.ldb);
  } else if constexpr (!BL::kDirect) {
    bp = bl.colptr(4 * bg) + (size_t)(bkg * 8) * bl.ldb;
  } else {
#pragma unroll
    for (int i = 0; i < 4; ++i) bdp[i] = bl.rowptr((t >> 3) + 32 * i) + kc * 8;
  }
  GemmStage<MT, AL, BL> st[DEPTH];
#pragma unroll
  for (int d = 0; d < DEPTH; ++d) gemm_load<MT, AL, BL>(st[d], al, bl, rh, bp, bdp, kc, 64 * d);

  constexpr bool DB = (MT <= 4) && (DEPTH == 1) && !NOLOAD;
  if constexpr (DB) {
    constexpr int STG = (BM + 128) * 64;
    gemm_store<MT, AL, BL>(st[0], sA, sB, t, kc, bg, bkg);
    __syncthreads();
    if (64 < K) gemm_load<MT, AL, BL>(st[0], al, bl, rh, bp, bdp, kc, 64);
    int cur = 0;
    for (int k0 = 0; k0 < K; k0 += 64) {
      gemm_compute<MT>(acc, sA + cur * STG, sB + cur * STG, wm, wn, c, q);
      if (k0 + 64 < K) gemm_store<MT, AL, BL>(st[0], sA + (cur ^ 1) * STG, sB + (cur ^ 1) * STG, t, kc, bg, bkg);
      if (k0 + 128 < K) gemm_load<MT, AL, BL>(st[0], al, bl, rh, bp, bdp, kc, k0 + 128);
      __syncthreads();
      cur ^= 1;
    }
  } else
  for (int k0 = 0; k0 < K; k0 += 64 * DEPTH) {
#pragma unroll
    for (int d = 0; d < DEPTH; ++d) {
      gemm_store<MT, AL, BL>(st[d], sA, sB, t, kc, bg, bkg);
      const int kn = k0 + 64 * (d + DEPTH);
      if (!NOLOAD && kn < K) gemm_load<MT, AL, BL>(st[d], al, bl, rh, bp, bdp, kc, kn);
      __syncthreads();
#ifdef SCHED_BAR
      __builtin_amdgcn_sched_barrier(0);
#endif
      gemm_compute<MT>(acc, sA, sB, wm, wn, c, q);
#ifdef SCHED_BAR
      __builtin_amdgcn_sched_barrier(0);
#endif
      __syncthreads();
    }
  }
  ep(acc, wm, wn, lane);
}

struct EpStoreF32 {
  float* C; int ldc; int m0, n0;
  template <int MT>
  __device__ __forceinline__ void operator()(f32x4 (&acc)[MT][4], int wm, int wn, int lane) const {
    const int c = lane & 15, q = lane >> 4;
#pragma unroll
    for (int mt = 0; mt < MT; ++mt)
#pragma unroll
      for (int nt = 0; nt < 4; ++nt)
#pragma unroll
        for (int j = 0; j < 4; ++j) {
          int row = m0 + wm * MT * 16 + mt * 16 + 4 * q + j;
          int col = n0 + wn * 64 + nt * 16 + c;
          C[(size_t)row * ldc + col] = acc[mt][nt][j];
        }
  }
};
struct EpResidual {
  float* pre; const float* xin; const float* gate; int m0, n0;
  template <int MT>
  __device__ __forceinline__ void operator()(f32x4 (&acc)[MT][4], int wm, int wn, int lane) const {
    const int c = lane & 15, q = lane >> 4;
    float gv[4];
#pragma unroll
    for (int nt = 0; nt < 4; ++nt) gv[nt] = gate[n0 + wn * 64 + nt * 16 + c];
#pragma unroll
    for (int mt = 0; mt < MT; ++mt) {
#pragma unroll
      for (int j = 0; j < 4; ++j) {
        const uint32_t ro = (uint32_t)(wm * MT * 16 + mt * 16 + 4 * q + j) * DM + n0 + wn * 64 + c;
#pragma unroll
        for (int nt = 0; nt < 4; ++nt)
          pre[ro + nt * 16] = ALPHA_F * xin[ro + nt * 16] + gv[nt] * acc[mt][nt][j];
      }
      __builtin_amdgcn_sched_barrier(0);
    }
  }
};
struct EpDft {
  float* yfn; int tok0; int n0; float scale;
  template <int MT>
  __device__ __forceinline__ void operator()(f32x4 (&acc)[MT][4], int wm, int wn, int lane) const {
    const int c = lane & 15, q = lane >> 4;
#pragma unroll
    for (int mt = 0; mt < MT; ++mt)
#pragma unroll
      for (int nt = 0; nt < 4; ++nt)
#pragma unroll
        for (int j = 0; j < 4; ++j) {
          int row = tok0 + wm * MT * 16 + mt * 16 + 4 * q + j;
          int col = n0 + wn * 64 + nt * 16 + c;
          unsafeAtomicAdd(yfn + (size_t)row * 256 + col, acc[mt][nt][j] * scale);
        }
  }
};
struct EpGateUp {
  bf16_t* h; int m0, n0g;
  template <int MT>
  __device__ __forceinline__ void operator()(f32x4 (&acc)[MT][4], int wm, int wn, int lane) const {
    const int c = lane & 15, q = lane >> 4;
#pragma unroll
    for (int mt = 0; mt < MT; ++mt)
#pragma unroll
      for (int ntp = 0; ntp < 2; ++ntp)
#pragma unroll
        for (int j = 0; j < 4; ++j) {
          int row = m0 + wm * MT * 16 + mt * 16 + 4 * q + j;
          int col = n0g + wn * 32 + ntp * 16 + c;
          float g = acc[mt][ntp][j], u = acc[mt][ntp + 2][j];
          h[(size_t)row * 2048 + col] = (bf16_t)f2bf(siluf_(g) * u);
        }
  }
};
struct EpDown {
  float* ye; int m0, n0;
  template <int MT>
  __device__ __forceinline__ void operator()(f32x4 (&acc)[MT][4], int wm, int wn, int lane) const {
    const int c = lane & 15, q = lane >> 4;
#pragma unroll
    for (int mt = 0; mt < MT; ++mt)
#pragma unroll
      for (int j = 0; j < 4; ++j) {
        const uint32_t ro = (uint32_t)(m0 + wm * MT * 16 + mt * 16 + 4 * q + j) * 1024u + n0 + wn * 64 + c;
#pragma unroll
        for (int nt = 0; nt < 4; ++nt) ye[ro + nt * 16] = acc[mt][nt][j];
      }
  }
};
struct OddPtrs { bf16_t *swaQ, *swaK, *swaVt, *diffQ, *diffK, *diffVt; float* out; };
struct EpOddProj {
  OddPtrs p; int m0, n0;
  template <int MT>
  __device__ __forceinline__ void operator()(f32x4 (&acc)[MT][4], int wm, int wn, int lane) const {
    const int c = lane & 15, q = lane >> 4;
    const int hb = (n0 + wn * 64) >> 6;
    const bool latent = m0 >= NCTX;
    const bool roped = latent && (hb < 10 || (hb >= 12 && hb < 28));
    const float invf = exp2f(-(float)c * (13.287712379549449f / 16.0f));
#pragma unroll
    for (int mt = 0; mt < MT; ++mt) {
      const int tokb = m0 + wm * MT * 16 + mt * 16 + 4 * q;
      float v[4][4];
#pragma unroll
      for (int nt = 0; nt < 4; ++nt)
#pragma unroll
        for (int j = 0; j < 4; ++j) v[nt][j] = acc[mt][nt][j];
      if (roped) {
#pragma unroll
        for (int j = 0; j < 4; ++j) {
          const int s = (tokb + j - NCTX) & 2047;
          const float prow = (float)(s >> 6), pcol = (float)(s & 63);
          float ar = prow * invf * 0.15915494309189535f, ac = pcol * invf * 0.15915494309189535f;
          float cr = __builtin_amdgcn_cosf(ar - floorf(ar)), sr = __builtin_amdgcn_sinf(ar - floorf(ar));
          float cc = __builtin_amdgcn_cosf(ac - floorf(ac)), sc = __builtin_amdgcn_sinf(ac - floorf(ac));
          float a1 = v[0][j], a2 = v[1][j];
          v[0][j] = a1 * cr - a2 * sr; v[1][j] = a2 * cr + a1 * sr;
          float b1 = v[2][j], b2 = v[3][j];
          v[2][j] = b1 * cc - b2 * sc; v[3][j] = b2 * cc + b1 * sc;
        }
      }
      if (hb < 8) {
#pragma unroll
        for (int nt = 0; nt < 4; ++nt)
#pragma unroll
          for (int j = 0; j < 4; ++j)
            p.swaQ[(size_t)(tokb + j) * 512 + hb * 64 + nt * 16 + c] = (bf16_t)f2bf(v[nt][j] * 0.125f);
      } else if (hb < 10) {
        const int kvh = hb - 8;
#pragma unroll
        for (int nt = 0; nt < 4; ++nt)
#pragma unroll
          for (int j = 0; j < 4; ++j) {
            p.swaK[((size_t)kvh * NTOK + tokb + j) * 64 + nt * 16 + c] = (bf16_t)f2bf(v[nt][j]);
            if (!latent) p.out[8413184 + ((size_t)(tokb + j) * 2 + kvh) * 64 + nt * 16 + c] = v[nt][j];
          }
      } else if (hb < 12) {
        const int kvh = hb - 10;
#pragma unroll
        for (int nt = 0; nt < 4; ++nt) {
          uint2 pk; pk.x = pack2(v[nt][0], v[nt][1]); pk.y = pack2(v[nt][2], v[nt][3]);
          *(uint2*)(p.swaVt + ((size_t)kvh * 64 + nt * 16 + c) * NTOK + tokb) = pk;
          if (!latent) {
#pragma unroll
            for (int j = 0; j < 4; ++j) p.out[8937472 + ((size_t)(tokb + j) * 2 + kvh) * 64 + nt * 16 + c] = v[nt][j];
          }
        }
      } else if (hb < 20) {
#pragma unroll
        for (int nt = 0; nt < 4; ++nt)
#pragma unroll
          for (int j = 0; j < 4; ++j)
            p.diffQ[(size_t)(tokb + j) * 512 + (hb - 12) * 64 + nt * 16 + c] = (bf16_t)f2bf(v[nt][j] * 0.125f);
      } else if (hb < 28) {
        const int hh = (hb - 20) >> 1, mm = (hb - 20) & 1;
#pragma unroll
        for (int nt = 0; nt < 4; ++nt)
#pragma unroll
          for (int j = 0; j < 4; ++j) {
            p.diffK[((size_t)hh * NTOK + tokb + j) * 128 + mm * 64 + nt * 16 + c] = (bf16_t)f2bf(v[nt][j]);
            if (!latent) p.out[9461760 + (size_t)(tokb + j) * 512 + (hb - 20) * 64 + nt * 16 + c] = v[nt][j];
          }
      } else {
        const int hh = (hb - 28) >> 1, dvb = ((hb - 28) & 1) * 64;
#pragma unroll
        for (int nt = 0; nt < 4; ++nt) {
          uint2 pk; pk.x = pack2(v[nt][0], v[nt][1]); pk.y = pack2(v[nt][2], v[nt][3]);
          *(uint2*)(p.diffVt + ((size_t)hh * 128 + dvb + nt * 16 + c) * NTOK + tokb) = pk;
          if (!latent) {
#pragma unroll
            for (int j = 0; j < 4; ++j) p.out[11558912 + (size_t)(tokb + j) * 512 + (hb - 28) * 64 + nt * 16 + c] = v[nt][j];
          }
        }
      }
    }
  }
};

__device__ __forceinline__ void prep_item(const Params& p, char* smem, int it) {
  const int t = tid(), lane = t & 63, w = t >> 6;
  if (it < 768) {
    const int l = it / 384, r = it % 384, n0 = (r >> 4) * 256, ks = r & 15;
    float* sc = (float*)smem;
    float* red = sc + 192;
    if (t < 192) {
      int v = t >> 6, k = ks * 64 + (t & 63);
      float cv = v == 0 ? p.c_ctx[k] : p.c[(v - 1) * 1024 + k];
      sc[t] = siluf_(cv);
    }
    const float* wp = p.w_mod + ((size_t)l * 1024 + ks * 64 + w * 16) * 6144 + n0 + lane * 4;
    float4 wv[16];
#pragma unroll
    for (int k = 0; k < 16; ++k) wv[k] = *(const float4*)(wp + (size_t)k * 6144);
    __syncthreads();
    float4 a0 = make_float4(0.f, 0.f, 0.f, 0.f), a1 = a0, a2 = a0;
#pragma unroll
    for (int k = 0; k < 16; ++k) {
      const float s0 = sc[w * 16 + k], s1 = sc[64 + w * 16 + k], s2 = sc[128 + w * 16 + k];
      a0.x += s0 * wv[k].x; a0.y += s0 * wv[k].y; a0.z += s0 * wv[k].z; a0.w += s0 * wv[k].w;
      a1.x += s1 * wv[k].x; a1.y += s1 * wv[k].y; a1.z += s1 * wv[k].z; a1.w += s1 * wv[k].w;
      a2.x += s2 * wv[k].x; a2.y += s2 * wv[k].y; a2.z += s2 * wv[k].z; a2.w += s2 * wv[k].w;
    }
    *(float4*)(red + (w * 3 + 0) * 256 + lane * 4) = a0;
    *(float4*)(red + (w * 3 + 1) * 256 + lane * 4) = a1;
    *(float4*)(red + (w * 3 + 2) * 256 + lane * 4) = a2;
    __syncthreads();
#pragma unroll
    for (int v = 0; v < 3; ++v) {
      float sm = red[(0 * 3 + v) * 256 + t] + red[(1 * 3 + v) * 256 + t] + red[(2 * 3 + v) * 256 + t] + red[(3 * 3 + v) * 256 + t];
      if (ks == 0) sm += p.b_mod[l * 6144 + n0 + t];
      unsafeAtomicAdd(p.mod + ((size_t)l * 3 + v) * 6144 + n0 + t, sm);
    }
    __syncthreads();
  } else if (it < 896) {
    const int o = (it - 768) * 256 + t;
    const int g = o >> 13, rem = o & 8191, n = rem >> 6, cc = rem & 63;
    const bool sn = n >= 64; const int d = n & 63;
    float s = 0.f;
    for (int kc = 0; kc < 64; ++kc) {
      float x = (float)((cc * kc) & 63) * (1.0f / 64.0f);
      float tr = sn ? __builtin_amdgcn_sinf(x) : __builtin_amdgcn_cosf(x);
      s += tr * p.e_w_fnet[((size_t)g * 64 + kc) * 64 + d];
    }
    p.wcsT[o] = (bf16_t)f2bf(s * 0.125f);
  } else if (it < 3456) {
    int e = (it - 896) * 256 + t;
    if (e < 65536) {
      int d = e & 63, key = (e >> 6) & 255, h = (e >> 14) & 1, b = e >> 15;
      p.cswaK[e] = (bf16_t)f2bf(p.cache_swa_k[(((size_t)b * 256 + key) * 2 + h) * 64 + d]);
    } else if (e < 131072) {
      e -= 65536;
      int key = e & 255, d = (e >> 8) & 63, h = (e >> 14) & 1, b = e >> 15;
      p.cswaVt[e] = (bf16_t)f2bf(p.cache_swa_v[(((size_t)b * 256 + key) * 2 + h) * 64 + d]);
    } else if (e < 131072 + 262144) {
      e -= 131072;
      int md = e & 127, key = (e >> 7) & 255, h = (e >> 15) & 3, b = e >> 17;
      p.cdiffK[e] = (bf16_t)f2bf(p.cache_diff_k[(((size_t)b * 256 + key) * 4 + h) * 128 + md]);
    } else {
      e -= 131072 + 262144;
      int key = e & 255, dv = (e >> 8) & 127, h = (e >> 15) & 3, b = e >> 17;
      p.cdiffVt[e] = (bf16_t)f2bf(p.cache_diff_v[(((size_t)b * 256 + key) * 4 + h) * 128 + dv]);
    }
  } else if (it < 3456 + 128) {
    const int o = (it - 3456) * 256 + t;
    const int l = o >> 14, r = o & 16383, e = r >> 10, k = r & 1023;
    p.wrT[o] = p.w_router[(size_t)l * 16384 + k * 16 + e];
  } else {
    if (t < 4) {
      float s1 = 0.f, s2 = 0.f;
      for (int d = 0; d < 64; ++d) {
        s1 += p.o_lambda[(0 * 4 + t) * 64 + d] * p.o_lambda[(1 * 4 + t) * 64 + d];
        s2 += p.o_lambda[(2 * 4 + t) * 64 + d] * p.o_lambda[(3 * 4 + t) * 64 + d];
      }
      p.lam[t] = expf(s1) - expf(s2) + LAM_INIT;
    }
  }
}

__device__ __forceinline__ void u0_phase(const Params& p) {
  const int nchunk = NTOK * DM / 8;
  for (int ci = blockIdx.x * 256 + tid(); ci < nchunk; ci += gridDim.x * 256) {
    const int token = ci >> 7, k = (ci & 127) * 8;
    const float* xr = token < NCTX ? p.x_prompt + (size_t)token * DM : p.x_sample + (size_t)(token - NCTX) * DM;
    const float* md = p.mod + (size_t)vec_of_token(token) * 6144;
    float4 xa = *(const float4*)(xr + k), xb = *(const float4*)(xr + k + 4);
    float4 sa = *(const float4*)(md + k), sb = *(const float4*)(md + k + 4);
    float4 ca = *(const float4*)(md + 1024 + k), cb = *(const float4*)(md + 1024 + k + 4);
    uint4 r;
    r.x = pack2(xa.x * (1.f + ca.x) + sa.x, xa.y * (1.f + ca.y) + sa.y);
    r.y = pack2(xa.z * (1.f + ca.z) + sa.z, xa.w * (1.f + ca.w) + sa.w);
    r.z = pack2(xb.x * (1.f + cb.x) + sb.x, xb.y * (1.f + cb.y) + sb.y);
    r.w = pack2(xb.z * (1.f + cb.z) + sb.z, xb.w * (1.f + cb.w) + sb.w);
    *(uint4*)(p.ubuf + (size_t)token * DM + k) = r;
  }
}

__device__ __forceinline__ void scan_item(const Params& p, char* smem, int item, bool final_pass) {
  const int t = tid(), lane = t & 63, w = t >> 6, c = lane & 15, q = lane >> 4;
  const int chunk = item / 12, head = item % 12;
  const int t0 = chunk * 64;
  int sb, seq_start, seq_len;
  if (t0 < NCTX) { sb = t0 >> 8; seq_start = sb << 8; seq_len = 256; }
  else { int b = (t0 - NCTX) >> 11; sb = 16 + b; seq_start = NCTX + (b << 11); seq_len = 2048; }
  const int seq_end = seq_start + seq_len;
  float* xcf = (float*)smem;
  bf16_t* xcb = (bf16_t*)(smem + 16384);
  bf16_t* wb = (bf16_t*)(smem + 25600);
  float* seg = (float*)(smem + 25600);

  float hcarry = 0.f;
  if (final_pass && t < 128) {
    const int d2 = t >> 6, gch = head * 64 + (t & 63);
    if (sb >= 16) hcarry = p.state_rglru[((sb - 16) * 2 + d2) * 768 + gch];
    const int cfirst = seq_start >> 6, clast = (seq_end >> 6) - 1;
    if (d2 == 0) {
#pragma unroll 16
      for (int cp = cfirst; cp < chunk; ++cp)
        hcarry = p.sumA[((size_t)cp * 2 + 0) * 768 + gch] * hcarry + p.sumB[((size_t)cp * 2 + 0) * 768 + gch];
    } else {
#pragma unroll 16
      for (int cp = clast; cp > chunk; --cp)
        hcarry = p.sumA[((size_t)cp * 2 + 1) * 768 + gch] * hcarry + p.sumB[((size_t)cp * 2 + 1) * 768 + gch];
    }
  }
  f32x4 rv[2][8];
#pragma unroll
  for (int ii = 0; ii < 2; ++ii) {
    const int pi = t + 256 * ii;
    const int g = pi & 63, kg = pi >> 6;
    const int n4 = 4 * g;
    const int wv = n4 >> 6, within = n4 & 63;
    const int is_i = within >> 5, dcol = (wv & 1) * 32 + (within & 31), dirw = wv >> 1;
    const float* src = (is_i ? p.e_w_igate : p.e_w_rgate) + (((size_t)dirw * 12 + head) * 64 + kg * 8) * 64 + dcol;
#pragma unroll
    for (int j = 0; j < 8; ++j) rv[ii][j] = *(const f32x4*)(src + j * 64);
  }
  {
    const int cc = t & 63, gch = head * 64 + cc;
    const float w0 = p.e_conv_w[0 * 768 + gch], w1 = p.e_conv_w[1 * 768 + gch], w2 = p.e_conv_w[2 * 768 + gch], w3 = p.e_conv_w[3 * 768 + gch];
    const float cb = p.e_conv_b[gch];
    float xr[19];
    float xv[16][4];
#pragma unroll
    for (int i = 0; i < 16; ++i) {
      const int tk = t0 + (t >> 6) + 4 * i;
      const float* xp = p.proj0 + (size_t)tk * 1792 + gch;
      xv[i][0] = (tk - 1 >= seq_start) ? xp[-1792] : 0.f;
      xv[i][1] = xp[0];
      xv[i][2] = (tk + 1 < seq_end) ? xp[1792] : 0.f;
      xv[i][3] = (tk + 2 < seq_end) ? xp[2 * 1792] : 0.f;
    }
    (void)xr;
#pragma unroll
    for (int i = 0; i < 16; ++i) {
      const int r = (t >> 6) + 4 * i;
      float xc = cb + w0 * xv[i][0] + w1 * xv[i][1] + w2 * xv[i][2] + w3 * xv[i][3];
      xcf[r * 64 + cc] = xc;
      xcb[r * 72 + cc] = (bf16_t)f2bf(xc);
    }
  }
#pragma unroll
  for (int ii = 0; ii < 2; ++ii) {
    const int pi = t + 256 * ii;
    const int g = pi & 63, kg = pi >> 6;
    const int n4 = 4 * g;
#pragma unroll
    for (int i = 0; i < 4; ++i) {
      const int n = n4 + i;
      u32x4 v;
      v.x = pack2(rv[ii][0][i], rv[ii][1][i]);
      v.y = pack2(rv[ii][2][i], rv[ii][3][i]);
      v.z = pack2(rv[ii][4][i], rv[ii][5][i]);
      v.w = pack2(rv[ii][6][i], rv[ii][7][i]);
      *(u32x4*)(wb + n * 72 + ((kg ^ ((n >> 4) & 3)) * 8)) = v;
    }
  }
  __syncthreads();
  f32x4 acc[4][4];
#pragma unroll
  for (int i = 0; i < 4; ++i)
#pragma unroll
    for (int j = 0; j < 4; ++j) acc[i][j] = f32x4{0.f, 0.f, 0.f, 0.f};
#pragma unroll
  for (int ks = 0; ks < 2; ++ks) {
    bf16x8 bfr[4];
#pragma unroll
    for (int nt = 0; nt < 4; ++nt) bfr[nt] = *(const bf16x8*)(wb + (w * 64 + nt * 16 + c) * 72 + (((ks * 4 + q) ^ nt) * 8));
#pragma unroll
    for (int mt = 0; mt < 4; ++mt) {
      bf16x8 afr = *(const bf16x8*)(xcb + (mt * 16 + c) * 72 + (ks * 4 + q) * 8);
#pragma unroll
      for (int nt = 0; nt < 4; ++nt) acc[mt][nt] = MFMA16(afr, bfr[nt], acc[mt][nt]);
    }
  }
  __syncthreads();
  const int dir = w >> 1, halfc = w & 1;
  float av[4][2][4], bv[4][2][4];
#pragma unroll
  for (int ntp = 0; ntp < 2; ++ntp) {
    const int ch = halfc * 32 + ntp * 16 + c, gch = head * 64 + ch;
    const float br = p.e_b_rgate[dir * 768 + gch], bi = p.e_b_igate[dir * 768 + gch];
    const float lamv = p.e_lambda[dir * 768 + gch];
    const float sp = log1pf(expf(-lamv));
#pragma unroll
    for (int mt = 0; mt < 4; ++mt) {
#pragma unroll
      for (int j = 0; j < 4; ++j) {
        const int r = mt * 16 + 4 * q + j;
        float rg = sigmoidf_(acc[mt][ntp][j] + br);
        float ig = sigmoidf_(acc[mt][ntp + 2][j] + bi);
        float log_a = -8.0f * sp * rg;
        float a = __builtin_amdgcn_exp2f(log_a * 1.4426950408889634f);
        float bt = __builtin_amdgcn_sqrtf(fmaxf(1.0f - a * a, 0.f)) * ig * xcf[r * 64 + ch];
        av[mt][ntp][j] = a; bv[mt][ntp][j] = bt;
      }
      float A, B;
      if (dir == 0) {
        A = av[mt][ntp][0]; B = bv[mt][ntp][0];
#pragma unroll
        for (int j = 1; j < 4; ++j) { B = B * av[mt][ntp][j] + bv[mt][ntp][j]; A *= av[mt][ntp][j]; }
      } else {
        A = av[mt][ntp][3]; B = bv[mt][ntp][3];
#pragma unroll
        for (int j = 2; j >= 0; --j) { B = B * av[mt][ntp][j] + bv[mt][ntp][j]; A *= av[mt][ntp][j]; }
      }
      const int sidx = mt * 4 + q;
      *(float2*)(seg + ((dir * 16 + sidx) * 64 + ch) * 2) = make_float2(A, B);
    }
  }
  __syncthreads();
  float gav[4][2][4];
  if (final_pass && dir == 0) {
#pragma unroll
    for (int ntp = 0; ntp < 2; ++ntp)
#pragma unroll
      for (int mt = 0; mt < 4; ++mt)
#pragma unroll
        for (int j = 0; j < 4; ++j)
          gav[mt][ntp][j] = p.proj0[(size_t)(t0 + mt * 16 + 4 * q + j) * 1792 + 768 + head * 64 + halfc * 32 + ntp * 16 + c];
  }
  if (t < 128) {
    const int d2 = t >> 6, ch = t & 63, gch = head * 64 + ch;
    if (!final_pass) {
      float h = 0.f, Ap = 1.f;
      for (int ss = 0; ss < 16; ++ss) {
        const int s = d2 == 0 ? ss : 15 - ss;
        float2 ab = *(const float2*)(seg + ((d2 * 16 + s) * 64 + ch) * 2);
        h = ab.x * h + ab.y; Ap *= ab.x;
      }
      p.sumA[((size_t)chunk * 2 + d2) * 768 + gch] = Ap;
      p.sumB[((size_t)chunk * 2 + d2) * 768 + gch] = h;
    } else {
      float h = hcarry;
      const int cfirst = seq_start >> 6, clast = (seq_end >> 6) - 1;
      for (int ss = 0; ss < 16; ++ss) {
        const int s = d2 == 0 ? ss : 15 - ss;
        float* sp2 = seg + ((d2 * 16 + s) * 64 + ch) * 2;
        float2 ab = *(const float2*)sp2;
        sp2[0] = h;
        h = ab.x * h + ab.y;
      }
      if (sb < 16) {
        if (d2 == 0 && chunk == clast) p.out[8388608 + (sb * 2 + 0) * 768 + gch] = h;
        if (d2 == 1 && chunk == cfirst) p.out[8388608 + (sb * 2 + 1) * 768 + gch] = h;
      }
    }
  }
  __syncthreads();
  if (final_pass) {
    float hv[4][2][4];
#pragma unroll
    for (int ntp = 0; ntp < 2; ++ntp) {
      const int ch = halfc * 32 + ntp * 16 + c;
#pragma unroll
      for (int mt = 0; mt < 4; ++mt) {
        const int sidx = mt * 4 + q;
        float h = seg[((dir * 16 + sidx) * 64 + ch) * 2];
        if (dir == 0) {
#pragma unroll
          for (int j = 0; j < 4; ++j) { h = av[mt][ntp][j] * h + bv[mt][ntp][j]; hv[mt][ntp][j] = h; }
        } else {
#pragma unroll
          for (int j = 3; j >= 0; --j) { h = av[mt][ntp][j] * h + bv[mt][ntp][j]; hv[mt][ntp][j] = h; }
        }
      }
    }
    if (dir == 1) {
#pragma unroll
      for (int ntp = 0; ntp < 2; ++ntp)
#pragma unroll
        for (int mt = 0; mt < 4; ++mt)
#pragma unroll
          for (int j = 0; j < 4; ++j) xcf[(mt * 16 + 4 * q + j) * 64 + halfc * 32 + ntp * 16 + c] = hv[mt][ntp][j];
    }
    __syncthreads();
    if (dir == 0) {
#pragma unroll
      for (int ntp = 0; ntp < 2; ++ntp)
#pragma unroll
        for (int mt = 0; mt < 4; ++mt)
#pragma unroll
          for (int j = 0; j < 4; ++j) {
            const int r = mt * 16 + 4 * q + j, ch = halfc * 32 + ntp * 16 + c, gch = head * 64 + ch;
            const int tk = t0 + r;
            float ga = gav[mt][ntp][j];
            float y = (hv[mt][ntp][j] + xcf[r * 64 + ch]) * gelu_tanh(ga);
            p.mixed[(size_t)tk * DM + gch] = (bf16_t)f2bf(y);
          }
    }
    __syncthreads();
  }
}

__device__ __forceinline__ void fnet_tok_item(const Params& p, char* smem, int chunk) {
  const int t = tid(), lane = t & 63, w = t >> 6, c = lane & 15, q = lane >> 4;
  const int t0 = chunk * 64;
  int sb, seq_start, S;
  if (t0 < NCTX) { sb = t0 >> 8; seq_start = sb << 8; S = 256; }
  else { int b = (t0 - NCTX) >> 11; sb = 16 + b; seq_start = NCTX + (b << 11); S = 2048; }
  bf16_t* sA = (bf16_t*)smem;
  for (int ci = t; ci < 64 * 64; ci += 256) *(float4*)(p.yfn + (size_t)t0 * 256 + ci * 4) = make_float4(0.f, 0.f, 0.f, 0.f);
  for (int ci = t; ci < 64 * 32; ci += 256) {
    const int r = ci >> 5, k = (ci & 31) * 8;
    const float* xp = p.proj0 + (size_t)(t0 + r) * 1792 + 1536 + k;
    float4 a = *(const float4*)xp, b = *(const float4*)(xp + 4);
    uint4 v; v.x = pack2(a.x, a.y); v.y = pack2(a.z, a.w); v.z = pack2(b.x, b.y); v.w = pack2(b.z, b.w);
    *(uint4*)(sA + r * 264 + k) = v;
  }
  __syncthreads();
  const int g = w;
  bf16_t* ytb = p.YT + (sb < 16 ? (size_t)sb * 256 * 512 : (size_t)16 * 256 * 512 + (size_t)(sb - 16) * 256 * 4096);
  const int s0 = t0 - seq_start;
#pragma unroll
  for (int part = 0; part < 2; ++part) {
    f32x4 acc[4][4];
#pragma unroll
    for (int i = 0; i < 4; ++i)
#pragma unroll
      for (int j = 0; j < 4; ++j) acc[i][j] = f32x4{0.f, 0.f, 0.f, 0.f};
#pragma unroll
    for (int ks = 0; ks < 2; ++ks) {
      bf16x8 bfr[4];
#pragma unroll
      for (int nt = 0; nt < 4; ++nt)
        bfr[nt] = *(const bf16x8*)(p.wcsT + ((size_t)g * 128 + part * 64 + nt * 16 + c) * 64 + ks * 32 + q * 8);
#pragma unroll
      for (int mt = 0; mt < 4; ++mt) {
        bf16x8 afr = *(const bf16x8*)(sA + (mt * 16 + c) * 264 + g * 64 + ks * 32 + q * 8);
#pragma unroll
        for (int nt = 0; nt < 4; ++nt) acc[mt][nt] = MFMA16(afr, bfr[nt], acc[mt][nt]);
      }
    }
#pragma unroll
    for (int mt = 0; mt < 4; ++mt)
#pragma unroll
      for (int nt = 0; nt < 4; ++nt) {
        const int n = g * 64 + nt * 16 + c;
        uint2 pk; pk.x = pack2(acc[mt][nt][0], acc[mt][nt][1]); pk.y = pack2(acc[mt][nt][2], acc[mt][nt][3]);
        *(uint2*)(ytb + (size_t)n * (2 * S) + part * S + s0 + mt * 16 + 4 * q) = pk;
      }
  }
  __syncthreads();
}

__device__ __forceinline__ void ln_router_phase(const Params& p, char* smem, int l) {
  const int t = tid(), lane = t & 63, w = t >> 6;
  float* wT = (float*)smem;
  const float* wr = p.wrT + (size_t)l * 16384;
  for (int i = t; i < 4096; i += 256) *(float4*)(wT + i * 4) = *(const float4*)(wr + i * 4);
  __syncthreads();
  const float* g = p.ln_g + (l * 2 + 0) * 1024;
  const float* b = p.ln_b + (l * 2 + 0) * 1024;
  float4 vn[4];
  {
    const int tk0 = blockIdx.x * 4 + w;
    if (tk0 < NTOK) {
#pragma unroll
      for (int i = 0; i < 4; ++i) vn[i] = *(const float4*)(p.pre + (size_t)tk0 * DM + i * 256 + lane * 4);
    }
  }
  for (int token = blockIdx.x * 4 + w; token < NTOK; token += gridDim.x * 4) {
    const float* md = p.mod + ((size_t)l * 3 + vec_of_token(token)) * 6144;
    float4 v[4];
    float s = 0.f;
#pragma unroll
    for (int i = 0; i < 4; ++i) { v[i] = vn[i]; s += v[i].x + v[i].y + v[i].z + v[i].w; }
    {
      const int tkn = token + gridDim.x * 4;
      if (tkn < NTOK) {
#pragma unroll
        for (int i = 0; i < 4; ++i) vn[i] = *(const float4*)(p.pre + (size_t)tkn * DM + i * 256 + lane * 4);
      }
    }
    float s2 = 0.f;
#pragma unroll
    for (int i = 0; i < 4; ++i) s2 += v[i].x * v[i].x + v[i].y * v[i].y + v[i].z * v[i].z + v[i].w * v[i].w;
    wave_sum2(s, s2);
    const float mean = s * (1.0f / 1024.0f);
    const float rstd = rsqrtf(fmaxf(s2 * (1.0f / 1024.0f) - mean * mean, 0.f) + 1e-5f);
    float4 tkv[4];
#pragma unroll
    for (int i = 0; i < 4; ++i) {
      const int k = i * 256 + lane * 4;
      float4 gg = *(const float4*)(g + k), bb = *(const float4*)(b + k);
      float4 x;
      x.x = (v[i].x - mean) * rstd * gg.x + bb.x; x.y = (v[i].y - mean) * rstd * gg.y + bb.y;
      x.z = (v[i].z - mean) * rstd * gg.z + bb.z; x.w = (v[i].w - mean) * rstd * gg.w + bb.w;
      float4 sf = *(const float4*)(md + 3072 + k), cf = *(const float4*)(md + 4096 + k);
      float4 tk;
      tk.x = x.x * (1.f + cf.x) + sf.x; tk.y = x.y * (1.f + cf.y) + sf.y;
      tk.z = x.z * (1.f + cf.z) + sf.z; tk.w = x.w * (1.f + cf.w) + sf.w;
      uint2 pk; pk.x = pack2(tk.x, tk.y); pk.y = pack2(tk.z, tk.w);
      *(uint2*)(p.tok + (size_t)token * DM + k) = pk;
      tkv[i] = tk;
    }
    float pe[16];
#pragma unroll
    for (int e = 0; e < 16; ++e) {
      float sacc = 0.f;
#pragma unroll
      for (int i = 0; i < 4; ++i) {
        float4 wv = *(const float4*)(wT + e * 1024 + i * 256 + lane * 4);
        sacc += tkv[i].x * wv.x + tkv[i].y * wv.y + tkv[i].z * wv.z + tkv[i].w * wv.w;
      }
      pe[e] = sacc;
      if ((e & 1) == 1) __builtin_amdgcn_sched_barrier(0);
    }
    const bool b5 = (lane & 32) != 0, b4 = (lane & 16) != 0, b3 = (lane & 8) != 0, b2 = (lane & 4) != 0;
    float r8[8], r4[4], r2[2];
#pragma unroll
    for (int i = 0; i < 8; ++i) { float keep = b5 ? pe[i + 8] : pe[i]; float send = b5 ? pe[i] : pe[i + 8]; r8[i] = keep + x32_partner(send, b5); }
#pragma unroll
    for (int i = 0; i < 4; ++i) { float keep = b4 ? r8[i + 4] : r8[i]; float send = b4 ? r8[i] : r8[i + 4]; r4[i] = keep + x16_partner(send, b4); }
#pragma unroll
    for (int i = 0; i < 2; ++i) { float keep = b3 ? r4[i + 2] : r4[i]; float send = b3 ? r4[i] : r4[i + 2]; r2[i] = keep + __shfl_xor(send, 8); }
    float mine;
    { float keep = b2 ? r2[1] : r2[0]; float send = b2 ? r2[0] : r2[1]; mine = keep + __shfl_xor(send, 4); }
    mine += __shfl_xor(mine, 2);
    mine += __shfl_xor(mine, 1);
    float mx = mine;
#pragma unroll
    for (int o = 8; o >= 4; o >>= 1) mx = fmaxf(mx, __shfl_xor(mx, o));
    mx = x32_max(x16_max(mx));
    float ex = expf(mine - mx);
    float den = ex;
#pragma unroll
    for (int o = 8; o >= 4; o >>= 1) den += __shfl_xor(den, o);
    den = x32_sum(x16_sum(den));
    mine = ex / den;
    if ((lane & 3) == 0) p.aff[(size_t)token * 16 + (lane >> 2)] = mine;
    if (lane == 1) p.tcount[token] = 0;
  }
  __syncthreads();
}

__device__ __forceinline__ void topk_item(const Params& p, char* smem, int item) {
  const int t = tid(), lane = t & 63, w = t >> 6;
  const int group = item >> 4, e = item & 15;
  int* wsum = (int*)smem;
  int* cnts = wsum + 8;
  uint32_t v[16];
#pragma unroll
  for (int i = 0; i < 16; ++i) v[i] = __float_as_uint(p.aff[((size_t)group * 4096 + t + 256 * i) * 16 + e]);
  if (t == 0) { cnts[0] = 0; cnts[1] = 0; }
  uint32_t prefix = 0;
  int par = 0;
  for (int bit = 30; bit >= 0; --bit) {
    const uint32_t cand = prefix | (1u << bit);
    int cnt = 0;
#pragma unroll
    for (int i = 0; i < 16; ++i) cnt += (v[i] >= cand) ? 1 : 0;
    cnt = wave_sum_i(cnt);
    if (lane == 0) wsum[par * 4 + w] = cnt;
    __syncthreads();
    const int tot = wsum[par * 4 + 0] + wsum[par * 4 + 1] + wsum[par * 4 + 2] + wsum[par * 4 + 3];
    if (tot >= 512) prefix = cand;
    par ^= 1;
  }
  int cnt = 0;
#pragma unroll
  for (int i = 0; i < 16; ++i) cnt += (v[i] > prefix) ? 1 : 0;
  cnt = wave_sum_i(cnt);
  if (lane == 0) wsum[par * 4 + w] = cnt;
  __syncthreads();
  const int cgt = wsum[par * 4 + 0] + wsum[par * 4 + 1] + wsum[par * 4 + 2] + wsum[par * 4 + 3];
  const int need = 512 - cgt;
  int* oi = p.idx + e * 1024 + group * 512;
  float* og = p.gsel + e * 1024 + group * 512;
#pragma unroll
  for (int i = 0; i < 16; ++i) {
    const int tk = group * 4096 + t + 256 * i;
    if (v[i] > prefix) {
      int slot = atomicAdd(&cnts[0], 1);
      oi[slot] = tk; og[slot] = __uint_as_float(v[i]);
      int jj = atomicAdd(&p.tcount[tk], 1);
      p.tlist[tk * 16 + jj] = e * 1024 + group * 512 + slot;
    } else if (v[i] == prefix) {
      int k = atomicAdd(&cnts[1], 1);
      if (k < need) {
        oi[cgt + k] = tk; og[cgt + k] = __uint_as_float(v[i]);
        int jj = atomicAdd(&p.tcount[tk], 1);
        p.tlist[tk * 16 + jj] = e * 1024 + group * 512 + cgt + k;
      }
    }
  }
  __syncthreads();
}

__device__ __forceinline__ void final_ln_phase(const Params& p, int l) {
  const int t = tid(), lane = t & 63, w = t >> 6;
  const float* g = p.ln_g + (l * 2 + 1) * 1024;
  const float* b = p.ln_b + (l * 2 + 1) * 1024;
  float4 xn[4];
  int cntn = 0, listn = 0;
  {
    const int tk0 = blockIdx.x * 4 + w;
    if (tk0 < NTOK) {
#pragma unroll
      for (int i = 0; i < 4; ++i) xn[i] = *(const float4*)(p.pre + (size_t)tk0 * DM + i * 256 + lane * 4);
      cntn = p.tcount[tk0];
      listn = p.tlist[tk0 * 16 + (lane & 15)];
    }
  }
  for (int token = blockIdx.x * 4 + w; token < NTOK; token += gridDim.x * 4) {
    const int vec = vec_of_token(token);
    const float* md = p.mod + ((size_t)l * 3 + vec) * 6144;
    float4 v[4];
    float4 xc[4], fc[4];
    const int cnt = cntn, mylist = listn;
#pragma unroll
    for (int i = 0; i < 4; ++i) { xc[i] = xn[i]; fc[i] = make_float4(0.f, 0.f, 0.f, 0.f); }
    {
      float s0 = 0.f;
#pragma unroll
      for (int i = 0; i < 4; ++i) s0 += xc[i].x + xc[i].y + xc[i].z + xc[i].w;
      float q0 = 0.f;
#pragma unroll
      for (int i = 0; i < 4; ++i) q0 += xc[i].x * xc[i].x + xc[i].y * xc[i].y + xc[i].z * xc[i].z + xc[i].w * xc[i].w;
      wave_sum2(s0, q0);
      const float mean0 = s0 * (1.0f / 1024.0f);
      const float rstd0 = rsqrtf(fmaxf(q0 * (1.0f / 1024.0f) - mean0 * mean0, 0.f) + 1e-5f);
      const float* g0 = p.ln_g + (l * 2 + 0) * 1024;
      const float* b0 = p.ln_b + (l * 2 + 0) * 1024;
#pragma unroll
      for (int i = 0; i < 4; ++i) {
        const int k = i * 256 + lane * 4;
        float4 gg = *(const float4*)(g0 + k), bb = *(const float4*)(b0 + k);
        xc[i].x = (xc[i].x - mean0) * rstd0 * gg.x + bb.x; xc[i].y = (xc[i].y - mean0) * rstd0 * gg.y + bb.y;
        xc[i].z = (xc[i].z - mean0) * rstd0 * gg.z + bb.z; xc[i].w = (xc[i].w - mean0) * rstd0 * gg.w + bb.w;
      }
    }
    {
      const int tkn = token + gridDim.x * 4;
      if (tkn < NTOK) {
#pragma unroll
        for (int i = 0; i < 4; ++i) xn[i] = *(const float4*)(p.pre + (size_t)tkn * DM + i * 256 + lane * 4);
        cntn = p.tcount[tkn];
        listn = p.tlist[tkn * 16 + (lane & 15)];
      }
    }
    for (int j = 0; j < cnt; j += 2) {
      const int id0 = __shfl(mylist, j);
      const bool has1 = (j + 1) < cnt;
      const int id1 = has1 ? __shfl(mylist, (j + 1) & 15) : id0;
      const float g0 = p.gsel[id0];
      const float g1 = has1 ? p.gsel[id1] : 0.f;
      float4 y0[4], y1[4];
#pragma unroll
      for (int i = 0; i < 4; ++i) {
        y0[i] = *(const float4*)(p.ye + (size_t)id0 * DM + i * 256 + lane * 4);
        y1[i] = *(const float4*)(p.ye + (size_t)id1 * DM + i * 256 + lane * 4);
      }
#pragma unroll
      for (int i = 0; i < 4; ++i) {
        fc[i].x += g0 * y0[i].x + g1 * y1[i].x; fc[i].y += g0 * y0[i].y + g1 * y1[i].y;
        fc[i].z += g0 * y0[i].z + g1 * y1[i].z; fc[i].w += g0 * y0[i].w + g1 * y1[i].w;
      }
    }
    float s = 0.f;
#pragma unroll
    for (int i = 0; i < 4; ++i) {
      const int k = i * 256 + lane * 4;
      float4 x = xc[i];
      float4 f = fc[i];
      float4 gf = *(const float4*)(md + 5120 + k);
      v[i].x = ALPHA_F * x.x + gf.x * f.x; v[i].y = ALPHA_F * x.y + gf.y * f.y;
      v[i].z = ALPHA_F * x.z + gf.z * f.z; v[i].w = ALPHA_F * x.w + gf.w * f.w;
      s += v[i].x + v[i].y + v[i].z + v[i].w;
    }
    float s2 = 0.f;
#pragma unroll
    for (int i = 0; i < 4; ++i) s2 += v[i].x * v[i].x + v[i].y * v[i].y + v[i].z * v[i].z + v[i].w * v[i].w;
    wave_sum2(s, s2);
    const float mean = s * (1.0f / 1024.0f);
    const float rstd = rsqrtf(fmaxf(s2 * (1.0f / 1024.0f) - mean * mean, 0.f) + 1e-5f);
    const float* md1 = p.mod + ((size_t)1 * 3 + vec) * 6144;
#pragma unroll
    for (int i = 0; i < 4; ++i) {
      const int k = i * 256 + lane * 4;
      float4 gg = *(const float4*)(g + k), bb = *(const float4*)(b + k);
      float4 x;
      x.x = (v[i].x - mean) * rstd * gg.x + bb.x; x.y = (v[i].y - mean) * rstd * gg.y + bb.y;
      x.z = (v[i].z - mean) * rstd * gg.z + bb.z; x.w = (v[i].w - mean) * rstd * gg.w + bb.w;
      if (l == 0) {
        *(float4*)(p.x2 + (size_t)token * DM + k) = x;
        float4 sa = *(const float4*)(md1 + k), ca = *(const float4*)(md1 + 1024 + k);
        uint2 pk;
        pk.x = pack2(x.x * (1.f + ca.x) + sa.x, x.y * (1.f + ca.y) + sa.y);
        pk.y = pack2(x.z * (1.f + ca.z) + sa.z, x.w * (1.f + ca.w) + sa.w);
        *(uint2*)(p.ubuf + (size_t)token * DM + k) = pk;
      } else {
        *(float4*)(p.out + (size_t)token * DM + k) = x;
      }
    }
  }
}

template <bool DIFF>
__device__ __forceinline__ void attn_item(const Params& p, char* smem, int sb, int head, int qt) {
  constexpr int DV = DIFF ? 128 : 64;
  constexpr int KW = DIFF ? 128 : 64;
  constexpr int KS = KW + 8;
  constexpr int NH = DIFF ? 4 : 2;
  const int t = tid(), lane = t & 63, w = t >> 6, c = lane & 15, q = lane >> 4;
  bf16_t* sK = (bf16_t*)smem;
  bf16_t* sV = (bf16_t*)(smem + 17408);
  const bool latent = sb >= 16;
  const int seq_start = latent ? NCTX + ((sb - 16) << 11) : (sb << 8);
  int qrow0, koff;
  const bf16_t* qbase;
  if (!DIFF) { qrow0 = qt * 32; koff = 0; qbase = p.swaQ + (head * 4 + w) * 64; }
  else { qrow0 = qt * 64 + (w >> 1) * 32; koff = (w & 1) * 64; qbase = p.diffQ + (head * 2 + (w & 1)) * 64; }
  bf16x8 qf[2][2];
#pragma unroll
  for (int nt = 0; nt < 2; ++nt)
#pragma unroll
    for (int ks = 0; ks < 2; ++ks)
      qf[nt][ks] = *(const bf16x8*)(qbase + (size_t)(seq_start + qrow0 + nt * 16 + c) * 512 + ks * 32 + q * 8);
  float m_[2], l_[2];
  f32x4 accO[DV / 16][2];
#pragma unroll
  for (int i = 0; i < DV / 16; ++i) { accO[i][0] = f32x4{0.f, 0.f, 0.f, 0.f}; accO[i][1] = f32x4{0.f, 0.f, 0.f, 0.f}; }
  if (!DIFF) { float sk = p.o_sink[head * 4 + w]; m_[0] = m_[1] = sk; l_[0] = l_[1] = (q == 0) ? 1.f : 0.f; }
  else { m_[0] = m_[1] = -1e30f; l_[0] = l_[1] = 0.f; }

  const bf16_t* Ksrc = (DIFF ? p.diffK : p.swaK) + (size_t)head * NTOK * KW;
  const bf16_t* Vsrc = (DIFF ? p.diffVt : p.swaVt) + (size_t)head * DV * NTOK;
  const bf16_t* cK = nullptr; const bf16_t* cV = nullptr;
  int ntiles, tlo = 0;
  if (!latent) ntiles = 4;
  else {
    const int b = sb - 16;
    cK = (DIFF ? p.cdiffK : p.cswaK) + (size_t)(b * NH + head) * 256 * KW;
    cV = (DIFF ? p.cdiffVt : p.cswaVt) + (size_t)(b * NH + head) * DV * 256;
    if (DIFF) ntiles = 4 + 32;
    else {
      int lo = qrow0 - 128; if (lo < 0) lo = 0;
      int hi = qrow0 + 31 + 128; if (hi > 2047) hi = 2047;
      tlo = lo >> 6;
      ntiles = 4 + ((hi >> 6) - tlo + 1);
    }
  }
  auto tile_ptrs = [&](int ti, const bf16_t*& kp, const bf16_t*& vp, int& vstride) {
    if (!latent) { kp = Ksrc + (size_t)(seq_start + 64 * ti) * KW; vp = Vsrc + seq_start + 64 * ti; vstride = NTOK; }
    else if (ti < 4) { kp = cK + (size_t)(64 * ti) * KW; vp = cV + 64 * ti; vstride = 256; }
    else { const int kt = tlo + ti - 4; kp = Ksrc + (size_t)(seq_start + 64 * kt) * KW; vp = Vsrc + seq_start + 64 * kt; vstride = NTOK; }
  };
  u32x4 rk[KW / 32], rvv[DV / 32];
  {
    const bf16_t* kp; const bf16_t* vp; int vstride;
    tile_ptrs(0, kp, vp, vstride);
#pragma unroll
    for (int i = 0; i < KW / 32; ++i) { const int ci = t + 256 * i; rk[i] = *(const u32x4*)(kp + (size_t)(ci / (KW / 8)) * KW + (ci % (KW / 8)) * 8); }
#pragma unroll
    for (int i = 0; i < DV / 32; ++i) { const int ci = t + 256 * i; rvv[i] = *(const u32x4*)(vp + (size_t)(ci >> 3) * vstride + (ci & 7) * 8); }
  }
  for (int ti = 0; ti < ntiles; ++ti) {
    bool masked = false; int kpos0 = 0;
    if (latent && ti >= 4) { masked = !DIFF; kpos0 = 64 * (tlo + ti - 4); }
#pragma unroll
    for (int i = 0; i < KW / 32; ++i) { const int ci = t + 256 * i; *(u32x4*)(sK + (ci / (KW / 8)) * KS + (ci % (KW / 8)) * 8) = rk[i]; }
#pragma unroll
    for (int i = 0; i < DV / 32; ++i) { const int ci = t + 256 * i; *(u32x4*)(sV + (ci >> 3) * 72 + (ci & 7) * 8) = rvv[i]; }
    __syncthreads();
    if (ti + 1 < ntiles) {
      const bf16_t* kp; const bf16_t* vp; int vstride;
      tile_ptrs(ti + 1, kp, vp, vstride);
#pragma unroll
      for (int i = 0; i < KW / 32; ++i) { const int ci = t + 256 * i; rk[i] = *(const u32x4*)(kp + (size_t)(ci / (KW / 8)) * KW + (ci % (KW / 8)) * 8); }
#pragma unroll
      for (int i = 0; i < DV / 32; ++i) { const int ci = t + 256 * i; rvv[i] = *(const u32x4*)(vp + (size_t)(ci >> 3) * vstride + (ci & 7) * 8); }
    }
    f32x4 s[4][2];
#pragma unroll
    for (int mt = 0; mt < 4; ++mt) { s[mt][0] = f32x4{0.f, 0.f, 0.f, 0.f}; s[mt][1] = f32x4{0.f, 0.f, 0.f, 0.f}; }
#pragma unroll
    for (int ks = 0; ks < 2; ++ks)
#pragma unroll
      for (int mt = 0; mt < 4; ++mt) {
        bf16x8 kf = *(const bf16x8*)(sK + (mt * 16 + c) * KS + koff + ks * 32 + q * 8);
        s[mt][0] = MFMA16(kf, qf[0][ks], s[mt][0]);
        s[mt][1] = MFMA16(kf, qf[1][ks], s[mt][1]);
      }
    __builtin_amdgcn_sched_barrier(0);
    bf16x8 pf[2][2];
#pragma unroll
    for (int nt = 0; nt < 2; ++nt) {
      if (masked) {
        const int qpos = qrow0 + nt * 16 + c;
#pragma unroll
        for (int mt = 0; mt < 4; ++mt)
#pragma unroll
          for (int j = 0; j < 4; ++j) {
            int d = qpos - (kpos0 + mt * 16 + 4 * q + j);
            if (d > 128 || d < -128) s[mt][nt][j] = -1e30f;
          }
      }
      float mx = -1e30f;
#pragma unroll
      for (int mt = 0; mt < 4; ++mt)
#pragma unroll
        for (int j = 0; j < 4; ++j) mx = fmaxf(mx, s[mt][nt][j]);
      mx = x32_max(x16_max(mx));
      const float mnew = fmaxf(m_[nt], mx);
      const float alpha = __expf(m_[nt] - mnew);
      m_[nt] = mnew;
      float ps = 0.f;
      float pv[4][4];
#pragma unroll
      for (int mt = 0; mt < 4; ++mt)
#pragma unroll
        for (int j = 0; j < 4; ++j) { pv[mt][j] = __expf(s[mt][nt][j] - mnew); ps += pv[mt][j]; }
      l_[nt] = l_[nt] * alpha + ps;
#pragma unroll
      for (int i = 0; i < DV / 16; ++i) { accO[i][nt][0] *= alpha; accO[i][nt][1] *= alpha; accO[i][nt][2] *= alpha; accO[i][nt][3] *= alpha; }
#pragma unroll
      for (int s2 = 0; s2 < 2; ++s2) {
        uint4 u;
        u.x = pack2(pv[2 * s2][0], pv[2 * s2][1]); u.y = pack2(pv[2 * s2][2], pv[2 * s2][3]);
        u.z = pack2(pv[2 * s2 + 1][0], pv[2 * s2 + 1][1]); u.w = pack2(pv[2 * s2 + 1][2], pv[2 * s2 + 1][3]);
        pf[nt][s2] = *(bf16x8*)&u;
      }
    }
    __builtin_amdgcn_sched_barrier(0);
#pragma unroll
    for (int s2 = 0; s2 < 2; ++s2)
#pragma unroll
      for (int dvt = 0; dvt < DV / 16; ++dvt) {
        const bf16_t* vr = sV + (dvt * 16 + c) * 72 + 32 * s2 + 4 * q;
        uint2 lo = *(const uint2*)vr, hi = *(const uint2*)(vr + 16);
        uint4 u; u.x = lo.x; u.y = lo.y; u.z = hi.x; u.w = hi.y;
        bf16x8 vf = *(bf16x8*)&u;
        accO[dvt][0] = MFMA16(vf, pf[0][s2], accO[dvt][0]);
        accO[dvt][1] = MFMA16(vf, pf[1][s2], accO[dvt][1]);
      }
    __syncthreads();
  }
  float inv[2];
#pragma unroll
  for (int nt = 0; nt < 2; ++nt) {
    float lt = l_[nt];
    lt = x32_sum(x16_sum(lt));
    inv[nt] = 1.0f / lt;
  }
  if (!DIFF) {
#pragma unroll
    for (int nt = 0; nt < 2; ++nt) {
      const int token = seq_start + qrow0 + nt * 16 + c;
#pragma unroll
      for (int dvt = 0; dvt < DV / 16; ++dvt) {
        uint2 pk;
        pk.x = pack2(accO[dvt][nt][0] * inv[nt], accO[dvt][nt][1] * inv[nt]);
        pk.y = pack2(accO[dvt][nt][2] * inv[nt], accO[dvt][nt][3] * inv[nt]);
        *(uint2*)(p.mixed + (size_t)token * DM + (head * 4 + w) * 64 + dvt * 16 + 4 * q) = pk;
      }
    }
  } else {
    float* sX = (float*)smem;
    const int sub = w >> 1;
    const float lamh = p.lam[head];
    if (w & 1) {
#pragma unroll
      for (int dvt = 0; dvt < DV / 16; ++dvt)
#pragma unroll
        for (int nt = 0; nt < 2; ++nt)
#pragma unroll
          for (int j = 0; j < 4; ++j) sX[((((dvt * 2 + nt) * 4 + j) * 2 + sub) << 6) + lane] = accO[dvt][nt][j] * inv[nt] * lamh;
    }
    __syncthreads();
    if (!(w & 1)) {
#pragma unroll
      for (int nt = 0; nt < 2; ++nt) {
        float ss = 0.f;
#pragma unroll
        for (int dvt = 0; dvt < DV / 16; ++dvt)
#pragma unroll
          for (int j = 0; j < 4; ++j) {
            float y = accO[dvt][nt][j] * inv[nt] - sX[((((dvt * 2 + nt) * 4 + j) * 2 + sub) << 6) + lane];
            accO[dvt][nt][j] = y; ss += y * y;
          }
        ss = x32_sum(x16_sum(ss));
        const float rs = rsqrtf(ss * (1.0f / 128.0f) + 1e-5f) * (1.0f - LAM_INIT);
        const int token = seq_start + qrow0 + nt * 16 + c;
#pragma unroll
        for (int dvt = 0; dvt < DV / 16; ++dvt) {
          const int dv = dvt * 16 + 4 * q;
          float4 gg = *(const float4*)(p.o_subln_g + dv);
          uint2 pk;
          pk.x = pack2(accO[dvt][nt][0] * rs * gg.x, accO[dvt][nt][1] * rs * gg.y);
          pk.y = pack2(accO[dvt][nt][2] * rs * gg.z, accO[dvt][nt][3] * rs * gg.w);
          *(uint2*)(p.mixed + (size_t)token * DM + 512 + head * 128 + dv) = pk;
        }
      }
    }
    __syncthreads();
  }
}


#define XB_TMO      128
#define XB_XCNT(j)  (256  + 64 * (j))
#define XB_XSUB(j)  (1280 + 64 * (j))
#define XB_XGEN(j)  (2304 + 64 * (j))
#define XB_TOP      3328
#define XB_TOPGEN   3392
#define XCD_BAR_WORDS 3456
#define XB_SPIN_CAP (1u << 22)
#define LAS __attribute__((address_space(3)))
__device__ __forceinline__ unsigned xb_ld(unsigned* p) { return __hip_atomic_load(p, __ATOMIC_RELAXED, __HIP_MEMORY_SCOPE_AGENT); }
__device__ __forceinline__ unsigned xb_add(unsigned* p, unsigned v) { return __hip_atomic_fetch_add(p, v, __ATOMIC_RELAXED, __HIP_MEMORY_SCOPE_AGENT); }
__device__ __forceinline__ unsigned xb_xcc_id() { return (unsigned)__builtin_amdgcn_s_getreg((3 << 11) | 20) & 0xFu; }
#define XB_SPIN(cond, bar) do { unsigned _sp = 0; while (cond) { __builtin_amdgcn_s_sleep(1); \
    if ((++_sp & 255u) == 0u) { if (xb_ld(&(bar)[XB_TMO])) break; if (_sp > XB_SPIN_CAP) { atomicAdd(&(bar)[XB_TMO], 1u); break; } } } } while (0)
struct XcdBarrier { unsigned* bar; unsigned x; volatile LAS unsigned* st; };
__device__ __forceinline__ XcdBarrier xcd_barrier_post(unsigned* bar, volatile LAS unsigned* st) {
  XcdBarrier b; b.bar = bar; b.x = xb_xcc_id(); b.st = st;
  if (threadIdx.x == 0) (void)xb_add(&bar[XB_XCNT(b.x)], 1u);
  return b;
}
__device__ __forceinline__ void xcd_barrier_complete(unsigned* bar, unsigned x, unsigned& nloc, unsigned& nx) {
  const unsigned G = gridDim.x * gridDim.y * gridDim.z;
  unsigned sum, cnt, mine, sp = 0u;
  for (;;) {
    sum = 0u; cnt = 0u; mine = 0u;
#pragma unroll
    for (unsigned j = 0; j < 16; ++j) { const unsigned c = xb_ld(&bar[XB_XCNT(j)]); sum += c; cnt += (c > 0u) ? 1u : 0u; mine = (j == x) ? c : mine; }
    if (sum == G) break;
    __builtin_amdgcn_s_sleep(1);
    if ((++sp & 255u) == 0u) { if (xb_ld(&bar[XB_TMO])) break; if (sp > XB_SPIN_CAP) { atomicAdd(&bar[XB_TMO], 1u); break; } }
  }
  nloc = mine > 0u ? mine : 1u; nx = cnt > 0u ? cnt : 1u;
}
__device__ __forceinline__ void xcd_barrier(const XcdBarrier& b) {
  asm volatile("s_waitcnt vmcnt(0)" ::: "memory");
  __syncthreads();
  if (threadIdx.x == 0) {
    unsigned* bar = b.bar;
    __builtin_amdgcn_s_waitcnt(0);
    unsigned nloc = b.st[0], nx = b.st[1];
    if (nloc == 0u) { xcd_barrier_complete(bar, b.x, nloc, nx); b.st[0] = nloc; b.st[1] = nx; }
    const unsigned old = xb_add(&bar[XB_XSUB(b.x)], 1u);
    const unsigned gen = old / nloc;
    if (old + 1u == (gen + 1u) * nloc) {
      __builtin_amdgcn_fence(__ATOMIC_RELEASE, "agent");
      asm volatile("s_waitcnt vmcnt(0)" ::: "memory");
      const unsigned og = xb_add(&bar[XB_TOP], 1u);
      const unsigned tg = og / nx;
      if (og + 1u == (tg + 1u) * nx) xb_add(&bar[XB_TOPGEN], 1u);
      else XB_SPIN(xb_ld(&bar[XB_TOPGEN]) == tg, bar);
      __builtin_amdgcn_fence(__ATOMIC_ACQUIRE, "agent");
      xb_add(&bar[XB_XGEN(b.x)], 1u);
      asm volatile("s_waitcnt vmcnt(0)" ::: "memory");
    } else {
      XB_SPIN(xb_ld(&bar[XB_XGEN(b.x)]) == gen, bar);
      __builtin_amdgcn_fence(__ATOMIC_ACQUIRE, "agent");
      asm volatile("s_waitcnt vmcnt(0)" ::: "memory");
    }
  }
  __syncthreads();
}

#define NPHASE 19
constexpr int PBM = PROJ_MT * 32, PNM = NTOK / PBM;
template <int ph, bool PROBE = false>
__device__ __forceinline__ void run_phase(const Params& p, char* smem) {
  const int nb = gridDim.x, bid = blockIdx.x;
  const int vb = (bid & 7) * (nb >> 3) + (bid >> 3);
  switch (ph) {
    case 0:
      for (int it = bid; it < 3457 + 128; it += nb) prep_item(p, smem, it);
      break;
    case 1:
      u0_phase(p);
      break;
    case 2:
      for (int it = bid; it < PNM * 14; it += nb) {
        const int mt = it % PNM, nt = it / PNM;
        ADirect al{p.ubuf + (size_t)mt * PBM * DM, DM};
        BWeight bl{p.e_w_in + nt * 128, 1792};
        EpStoreF32 ep{p.proj0, 1792, mt * PBM, nt * 128};
        gemm_tile<PROJ_MT, GD4>(smem, 1024, al, bl, ep);
      }
      break;
    case 3:
      for (int it = bid; it < 128; it += nb) fnet_tok_item(p, smem, it);
      for (int it = (bid + nb - 128) % nb; it < 1536; it += nb) scan_item(p, smem, it, false);
      break;
    case 4:
      for (int it = bid; it < 576; it += nb) {
        if (it < 512) {
          const int b = it >> 8, r = it & 255, mt = r >> 4, nt = (r >> 3) & 1, ksl = r & 7;
          ADft al{mt * 128, 2048, 2047, 1.0f / 2048.0f, ksl * 512};
          BDirect bl{p.YT + (size_t)16 * 256 * 512 + (size_t)b * 256 * 4096 + (size_t)nt * 128 * 4096 + ksl * 512, 4096};
          EpDft ep{p.yfn, NCTX + b * 2048 + mt * 128, nt * 128, 0.02209708691207961f};
          gemm_tile<4, 1>(smem, 512, al, bl, ep);
        } else {
          const int r = it - 512, b = r >> 2, mt = (r >> 1) & 1, nt = r & 1;
          ADft al{mt * 128, 256, 255, 1.0f / 256.0f, 0};
          BDirect bl{p.YT + (size_t)b * 256 * 512 + (size_t)nt * 128 * 512, 512};
          EpDft ep{p.yfn, b * 256 + mt * 128, nt * 128, 0.0625f};
          gemm_tile<4, 1>(smem, 512, al, bl, ep);
        }
      }
      for (int it = (bid + nb - 64) % nb; it < 1536; it += nb) scan_item(p, smem, it, true);
      break;
    case 5:
    case 12: {
      const int l = ph == 5 ? 0 : 1;
      for (int it = bid; it < PNM * 8; it += nb) {
        const int mt = it % PNM, nt = it / PNM;
        BWeight bl{(l == 0 ? p.e_w_out : p.o_w_out) + nt * 128, 1024};
        const int vec = vec_of_token(mt * PBM);
        const int r0 = mt * PBM;
        const float* xin = l == 0 ? (r0 < NCTX ? p.x_prompt + (size_t)r0 * DM : p.x_sample + (size_t)(r0 - NCTX) * DM) : p.x2 + (size_t)r0 * DM;
        EpResidual ep{p.pre + (size_t)r0 * DM, xin, p.mod + ((size_t)l * 3 + vec) * 6144 + 2048, r0, nt * 128};
        if (l == 0) {
          AMixedFn al{p.mixed + (size_t)r0 * DM, p.yfn + (size_t)r0 * 256};
          gemm_tile<PROJ_MT, GD4>(smem, 1024, al, bl, ep);
        } else {
          ADirect al{p.mixed + (size_t)r0 * DM, DM};
          gemm_tile<PROJ_MT, GD4>(smem, 1024, al, bl, ep);
        }
      }
    } break;
    case 6:
    case 13:
      ln_router_phase(p, smem, ph == 6 ? 0 : 1);
      break;
    case 7:
    case 14:
      for (int it = bid; it < 32; it += nb) topk_item(p, smem, it);
      break;
    case 8:
    case 15: {
      const int l = ph == 8 ? 0 : 1;
      constexpr int NMT = 32 / MOE_MT;
      for (int it = vb; it < 16 * 32 * NMT; it += nb) {
        const int e = it / (32 * NMT), r = it % (32 * NMT), nt = r / NMT, mt = r % NMT;
        AGather al{p.tok, p.idx + e * 1024 + mt * (MOE_MT * 32), DM};
        const size_t wo = ((size_t)l * 16 + e) * 1024 * 2048 + nt * 64;
        BGateUp bl{p.w_gate + wo, (long long)((const char*)p.w_up - (const char*)p.w_gate), 2048};
        EpGateUp ep{(PROBE ? (bf16_t*)p.ye : p.hbuf) + (size_t)e * 1024 * 2048, mt * (MOE_MT * 32), nt * 64};
        gemm_tile<MOE_MT, MOE_D, PROBE>(smem, 1024, al, bl, ep);
      }
    } break;
    case 9:
    case 16: {
      const int l = ph == 9 ? 0 : 1;
      constexpr int NMT = 32 / MOE_MT;
      for (int it = vb; it < 16 * 8 * NMT; it += nb) {
        const int e = it / (8 * NMT), r = it % (8 * NMT), nt = r / NMT, mt = r % NMT;
        ADirect al{p.hbuf + ((size_t)e * 1024 + mt * (MOE_MT * 32)) * 2048, 2048};
        BWeight bl{p.w_down + ((size_t)l * 16 + e) * 2048 * 1024 + nt * 128, 1024};
        EpDown ep{p.ye + (size_t)e * 1024 * 1024, mt * (MOE_MT * 32), nt * 128};
        gemm_tile<MOE_MT, MOE_D>(smem, 2048, al, bl, ep);
      }
    } break;
    case 10:
    case 17:
      final_ln_phase(p, ph == 10 ? 0 : 1);
      break;
    case 11:
      for (int it = bid; it < PNM * 18; it += nb) {
        const int mt = it % PNM, nt = it / PNM;
        ADirect al{p.ubuf + (size_t)mt * PBM * DM, DM};
        BWeight bl{p.o_w_in + nt * 128, 2304};
        EpOddProj ep{OddPtrs{p.swaQ, p.swaK, p.swaVt, p.diffQ, p.diffK, p.diffVt, p.out}, mt * PBM, nt * 128};
        gemm_tile<PROJ_MT, GD4>(smem, 1024, al, bl, ep);
      }
      break;
    case 18:
      for (int it = bid; it < 512; it += nb) {
        if (it < 256) {
          const int h = (it & 7) * 32 + (it >> 3);
          attn_item<true>(p, smem, 16 + (h >> 7), (h >> 5) & 3, h & 31);
        }
        else { const int r = it - 256; attn_item<true>(p, smem, r >> 4, (r >> 2) & 3, r & 3); }
      }
      for (int it = nb - 1 - bid; it < 512; it += nb) {
        if (it < 256) {
          const int j = 255 - it, x = j & 7;
          const int h = (x >> 1) * 64 + (x & 1) * 32 + (j >> 3);
          attn_item<false>(p, smem, 16 + (h >> 7), (h >> 6) & 1, h & 63);
        }
        else { const int r = it - 256; attn_item<false>(p, smem, r >> 4, (r >> 3) & 1, r & 7); }
      }
      break;
  }
}

#ifndef DUP_PROBE
#define DUP_PROBE false
#endif
#ifndef DUP_MASK
#define DUP_MASK 0u
#endif
#ifndef PHASE_MASK
#define PHASE_MASK 0x7ffffu
#endif
#define STEP(i, PH)                                              \
  if (((PHASE_MASK >> (i)) & 1u) && lo <= (i) && (i) < hi) {      \
    run_phase<PH>(p, smem);                                       \
    if (COOP && ((DUP_MASK >> (i)) & 1u)) { xcd_barrier(xb); run_phase<PH, DUP_PROBE>(p, smem); }   \
    if (COOP && (i) + 1 < hi) xcd_barrier(xb);                    \
  }

template <bool COOP>
__global__ void __launch_bounds__(256, 2) mega_kernel(Params p, int lo_, int hi_) {
  __shared__ __attribute__((aligned(16))) char smem[65536];
  const int lo = COOP ? 0 : lo_, hi = COOP ? NPHASE : hi_;
  __shared__ uint4 xb_words;
  XcdBarrier xb;
  if (COOP) {
    if (threadIdx.x == 0) xb_words = make_uint4(0u, 0u, 0u, 0u);
    __syncthreads();
    xb = xcd_barrier_post(p.bar, (volatile LAS unsigned*)&xb_words);
    if (hi_ == 12345) cg::this_grid().sync();
  }
  STEP(0, 0) STEP(1, 1) STEP(2, 2) STEP(3, 3) STEP(4, 4) STEP(5, 5) STEP(6, 6) STEP(7, 7) STEP(8, 8) STEP(9, 9)
  STEP(10, 10) STEP(11, 11) STEP(12, 18) STEP(13, 12) STEP(14, 13) STEP(15, 14) STEP(16, 15) STEP(17, 16) STEP(18, 17)
}

extern "C" void kernel_launch(void* const* d_in, const int* in_sizes, int n_in, void* d_out, int out_size,
                              void* d_ws, size_t ws_size, hipStream_t stream) {
  Params p;
  memset(&p, 0, sizeof(p));
  const float** pin = (const float**)&p;
  for (int i = 0; i < 32; ++i) pin[i] = (const float*)d_in[i];
  p.out = (float*)d_out;
  char* ws = (char*)d_ws;
  size_t off = 0;
  auto take = [&](size_t bytes) { char* r = ws + off; off += (bytes + 255) & ~(size_t)255; return r; };
  p.bar = (unsigned*)take(XCD_BAR_WORDS * 4);
  p.mod = (float*)take(2 * 3 * 6144 * 4);
  p.cnt = (unsigned*)take(1024);
  p.wcsT = (bf16_t*)take(32768 * 2);
  p.wrT = (float*)take(2 * 16384 * 4);
  p.lam = (float*)take(256);
  p.cswaK = (bf16_t*)take(65536 * 2);
  p.cswaVt = (bf16_t*)take(65536 * 2);
  p.cdiffK = (bf16_t*)take(262144 * 2);
  p.cdiffVt = (bf16_t*)take(262144 * 2);
  p.ubuf = (bf16_t*)take((size_t)NTOK * DM * 2);
  p.proj0 = (float*)take((size_t)NTOK * 1792 * 4);
  p.sumA = (float*)take(128 * 2 * 768 * 4);
  p.sumB = (float*)take(128 * 2 * 768 * 4);
  p.YT = (bf16_t*)take((size_t)4194304 * 2);
  p.yfn = (float*)take((size_t)NTOK * 256 * 4);
  p.mixed = (bf16_t*)take((size_t)NTOK * DM * 2);
  p.pre = (float*)take((size_t)NTOK * DM * 4);
  p.x1 = (float*)take((size_t)NTOK * DM * 4);
  p.tok = (bf16_t*)take((size_t)NTOK * DM * 2);
  p.aff = (float*)take((size_t)NTOK * 16 * 4);
  p.idx = (int*)take(16 * 1024 * 4);
  p.gsel = (float*)take(16 * 1024 * 4);
  p.hbuf = (bf16_t*)take((size_t)16 * 1024 * 2048 * 2);
  p.ffn = (float*)take(256);
  p.ye = (float*)take((size_t)16 * 1024 * 1024 * 4);
  p.tcount = (int*)take(NTOK * 4);
  p.tlist = (int*)take(NTOK * 16 * 4);
  p.x2 = (float*)take((size_t)NTOK * DM * 4);
  p.swaQ = (bf16_t*)take((size_t)NTOK * 512 * 2);
  p.swaK = (bf16_t*)take((size_t)2 * NTOK * 64 * 2);
  p.swaVt = (bf16_t*)take((size_t)2 * 64 * NTOK * 2);
  p.diffQ = (bf16_t*)take((size_t)NTOK * 512 * 2);
  p.diffK = (bf16_t*)take((size_t)4 * NTOK * 128 * 2);
  p.diffVt = (bf16_t*)take((size_t)4 * 128 * NTOK * 2);

  static int grid_blocks = 0;
  if (!grid_blocks) {
    int dev = 0, cus = 0, per_cu = 0;
    (void)hipGetDevice(&dev);
    (void)hipDeviceGetAttribute(&cus, hipDeviceAttributeMultiprocessorCount, dev);
    (void)hipOccupancyMaxActiveBlocksPerMultiprocessor(&per_cu, mega_kernel<MULTI_LAUNCH == 0>, 256, 0);
    if (per_cu > 2) per_cu = 2;
    if (per_cu < 1) per_cu = 1;
    grid_blocks = cus * per_cu;
    grid_blocks &= ~7;
  }
#if MULTI_LAUNCH
  for (int i = 0; i < NPHASE; ++i) {
    hipLaunchKernelGGL(mega_kernel<false>, dim3(grid_blocks), dim3(256), 0, stream, p, i, i + 1);
  }
#else
  (void)hipMemsetAsync(p.bar, 0, XCD_BAR_WORDS * 4 + 2 * 3 * 6144 * 4 + 1024, stream);
  int lo = 0, hi = NPHASE;
  void* args[] = {&p, &lo, &hi};
  hipError_t e = hipLaunchCooperativeKernel((void*)mega_kernel<true>, dim3(grid_blocks), dim3(256), args, 0, stream);
  if (e != hipSuccess) fprintf(stderr, "cooperative launch failed: %s (grid %d)\n", hipGetErrorString(e), grid_blocks);
#endif
}
```

```cpp
#include <hip/hip_runtime.h>
#include <hip/hip_cooperative_groups.h>
#include <stdint.h>
#include <stdio.h>
#include <string.h>
namespace cg = cooperative_groups;

#ifndef GD4
#define GD4 1
#endif
#ifndef PROJ_MT
#define PROJ_MT 4
#endif
#ifndef MOE_MT
#define MOE_MT 8
#endif
#ifndef MOE_D
#define MOE_D 1
#endif
#ifndef MULTI_LAUNCH
#define MULTI_LAUNCH 0
#endif

typedef __attribute__((ext_vector_type(8))) short bf16x8;
typedef __attribute__((ext_vector_type(4))) float f32x4;
typedef unsigned short bf16_t;
typedef __attribute__((ext_vector_type(4))) unsigned int u32x4;

#define NTOK 8192
#define NCTX 4096
#define DM 1024
#define ALPHA_F 1.4142135623730951f
#define LAM_INIT 0.35550906759f

struct Params {
  const float *x_prompt, *x_sample, *state_rglru, *cache_swa_k, *cache_swa_v, *cache_diff_k, *cache_diff_v;
  const float *c, *c_ctx, *w_mod, *b_mod, *ln_g, *ln_b;
  const float *e_w_in, *e_conv_w, *e_conv_b, *e_w_rgate, *e_b_rgate, *e_w_igate, *e_b_igate, *e_lambda, *e_w_fnet, *e_w_out;
  const float *o_w_in, *o_sink, *o_lambda, *o_subln_g, *o_w_out;
  const float *w_router, *w_gate, *w_up, *w_down;
  float* out;
  unsigned* bar;
  unsigned* cnt;
  float* mod;
  bf16_t* wcsT;
  float* wrT;
  float* lam;
  bf16_t *cswaK, *cswaVt, *cdiffK, *cdiffVt;
  bf16_t* ubuf;
  float* proj0;
  float *sumA, *sumB;
  bf16_t* YT;
  float* yfn;
  bf16_t* mixed;
  float* pre;
  float* x1;
  bf16_t* tok;
  float* aff;
  int* idx;
  float* gsel;
  bf16_t* hbuf;
  float* ffn;
  float* ye;
  int* tcount;
  int* tlist;
  float* x2;
  bf16_t *swaQ, *swaK, *swaVt, *diffQ, *diffK, *diffVt;
};

__device__ __forceinline__ int tid() { int t = threadIdx.x; asm volatile("" : "+v"(t)); return t; }
typedef __attribute__((ext_vector_type(2))) float f32x2_t;
typedef __attribute__((ext_vector_type(2))) __bf16 bf16x2_t;
__device__ __forceinline__ uint32_t pack2(float a, float b) {
  f32x2_t v = {a, b};
  bf16x2_t r = __builtin_convertvector(v, bf16x2_t);
  return *(uint32_t*)&r;
}
__device__ __forceinline__ uint32_t f2bf(float f) { return pack2(f, 0.f) & 0xffffu; }
typedef __attribute__((ext_vector_type(2))) unsigned u32x2;
template <int CTRL>
__device__ __forceinline__ float dpp_add(float v) {
  int t = __builtin_amdgcn_update_dpp(0, __float_as_int(v), CTRL, 0xf, 0xf, false);
  return v + __int_as_float(t);
}
__device__ __forceinline__ float row_allsum(float v) {
  v = dpp_add<0x128>(v); v = dpp_add<0x124>(v); v = dpp_add<0x122>(v); v = dpp_add<0x121>(v);
  return v;
}
__device__ __forceinline__ float x16_sum(float v) { u32x2 r = __builtin_amdgcn_permlane16_swap(__float_as_uint(v), __float_as_uint(v), false, false); return __uint_as_float(r[0]) + __uint_as_float(r[1]); }
__device__ __forceinline__ float x32_sum(float v) { u32x2 r = __builtin_amdgcn_permlane32_swap(__float_as_uint(v), __float_as_uint(v), false, false); return __uint_as_float(r[0]) + __uint_as_float(r[1]); }
__device__ __forceinline__ float x16_max(float v) { u32x2 r = __builtin_amdgcn_permlane16_swap(__float_as_uint(v), __float_as_uint(v), false, false); return fmaxf(__uint_as_float(r[0]), __uint_as_float(r[1])); }
__device__ __forceinline__ float x32_max(float v) { u32x2 r = __builtin_amdgcn_permlane32_swap(__float_as_uint(v), __float_as_uint(v), false, false); return fmaxf(__uint_as_float(r[0]), __uint_as_float(r[1])); }
__device__ __forceinline__ float x32_partner(float v, bool hi) { u32x2 r = __builtin_amdgcn_permlane32_swap(__float_as_uint(v), __float_as_uint(v), false, false); return __uint_as_float(hi ? r[0] : r[1]); }
__device__ __forceinline__ float x16_partner(float v, bool odd) { u32x2 r = __builtin_amdgcn_permlane16_swap(__float_as_uint(v), __float_as_uint(v), false, false); return __uint_as_float(odd ? r[0] : r[1]); }
__device__ __forceinline__ float wave_sum(float v) { return x32_sum(x16_sum(row_allsum(v))); }
__device__ __forceinline__ void wave_sum2(float& a, float& b) {
  a = row_allsum(a); b = row_allsum(b);
  a = x16_sum(a); b = x16_sum(b);
  a = x32_sum(a); b = x32_sum(b);
}
__device__ __forceinline__ int wave_sum_i(int v) {
#pragma unroll
  for (int o = 32; o; o >>= 1) v += __shfl_xor(v, o);
  return v;
}
__device__ __forceinline__ float sigmoidf_(float x) { return __builtin_amdgcn_rcpf(1.0f + __expf(-x)); }
__device__ __forceinline__ float siluf_(float x) { return x * __builtin_amdgcn_rcpf(1.0f + __expf(-x)); }
__device__ __forceinline__ float gelu_tanh(float x) {
  float y = 0.7978845608028654f * (x + 0.044715f * x * x * x);
  float e = __expf(2.0f * y);
  float th = 1.0f - 2.0f * __builtin_amdgcn_rcpf(e + 1.0f);
  return 0.5f * x * (1.0f + th);
}
__device__ __forceinline__ int vec_of_token(int token) { return token < NCTX ? 0 : 1 + ((token - NCTX) >> 11); }

#define MFMA16(a, b, c) __builtin_amdgcn_mfma_f32_16x16x32_bf16((a), (b), (c), 0, 0, 0)

struct ADirect {
  const bf16_t* base; int lda;
  typedef uint32_t RowH;
  __device__ __forceinline__ RowH row(int r) const { return (uint32_t)r * (uint32_t)lda; }
  __device__ __forceinline__ u32x4 load(RowH h, int k) const { return *(const u32x4*)(base + h + k); }
};
struct AGather {
  const bf16_t* base; const int* idx; int lda;
  typedef uint32_t RowH;
  __device__ __forceinline__ RowH row(int r) const { return (uint32_t)idx[r] * (uint32_t)lda; }
  __device__ __forceinline__ u32x4 load(RowH h, int k) const { return *(const u32x4*)(base + h + k); }
};
struct ADft {
  int m0, S, smask; float invS; int koff;
  typedef int RowH;
  __device__ __forceinline__ RowH row(int r) const { return m0 + r; }
  __device__ __forceinline__ u32x4 load(RowH ks, int kk) const {
    const int k = kk + koff;
    const bool part = k >= S;
    const int s0 = part ? k - S : k;
    float v[8];
    int id = (ks * s0) & smask;
    if (part) {
#pragma unroll
      for (int i = 0; i < 8; ++i) { v[i] = -__builtin_amdgcn_sinf((float)id * invS); id = (id + ks) & smask; }
    } else {
#pragma unroll
      for (int i = 0; i < 8; ++i) { v[i] = __builtin_amdgcn_cosf((float)id * invS); id = (id + ks) & smask; }
    }
    u32x4 r;
    r.x = pack2(v[0], v[1]); r.y = pack2(v[2], v[3]); r.z = pack2(v[4], v[5]); r.w = pack2(v[6], v[7]);
    return r;
  }
};
struct AMixedFn {
  const bf16_t* mixed; const float* yfn;
  typedef uint32_t RowH;
  __device__ __forceinline__ RowH row(int r) const { return (uint32_t)r; }
  __device__ __forceinline__ u32x4 load(RowH h, int k) const {
    if (k < 768) return *(const u32x4*)(mixed + h * 1024u + k);
    const float* f = yfn + h * 256u + (k - 768);
    f32x4 a = *(const f32x4*)f, b = *(const f32x4*)(f + 4);
    u32x4 r;
    r.x = pack2(a[0], a[1]); r.y = pack2(a[2], a[3]); r.z = pack2(b[0], b[1]); r.w = pack2(b[2], b[3]);
    return r;
  }
};
struct BWeight {
  static constexpr bool kDirect = false;
  static constexpr bool kUniform = true;
  const float* base; int ldb;
  __device__ __forceinline__ const float* colptr(int n4) const { return base + n4; }
};
struct BGateUp {
  static constexpr bool kDirect = false;
  static constexpr bool kUniform = false;
  const float* wg; long long du; int ldb;
  __device__ __forceinline__ const float* colptr(int n4) const {
    int wn = n4 >> 6, within = n4 & 63;
    int col = wn * 32 + (within & 31);
    return (const float*)((const char*)wg + (long long)(within >> 5) * du) + col;
  }
};
struct BDirect {
  static constexpr bool kDirect = true;
  static constexpr bool kUniform = false;
  const bf16_t* base; int ldk;
  __device__ __forceinline__ const bf16_t* rowptr(int n) const { return base + (size_t)n * ldk; }
};

template <int MT, class AL, class BL>
struct GemmStage {
  u32x4 ra[MT];
  f32x4 rbw[8];
  u32x4 rbd[4];
};

template <int MT, class AL, class BL>
__device__ __forceinline__ void gemm_load(GemmStage<MT, AL, BL>& st, const AL& al, const BL& bl, const typename AL::RowH (&rh)[MT],
                                          const float* bp, const bf16_t* const (&bdp)[4], int kc, int k0) {
#pragma unroll
  for (int i = 0; i < MT; ++i) st.ra[i] = al.load(rh[i], k0 + kc * 8);
  if constexpr (!BL::kDirect && BL::kUniform) {
    const uint32_t boff = (uint32_t)(uintptr_t)bp;
#pragma unroll
    for (int j = 0; j < 8; ++j) {
      const float* rowb = bl.base + (size_t)(k0 + j) * bl.ldb;
      st.rbw[j] = *(const f32x4*)(rowb + boff);
    }
  } else if constexpr (!BL::kDirect) {
    const float* bq = bp + (size_t)k0 * bl.ldb;
#pragma unroll
    for (int j = 0; j < 8; ++j) st.rbw[j] = *(const f32x4*)(bq + (size_t)j * bl.ldb);
  } else {
#pragma unroll
    for (int i = 0; i < 4; ++i) st.rbd[i] = *(const u32x4*)(bdp[i] + k0);
  }
}

template <int MT, class AL, class BL>
__device__ __forceinline__ void gemm_store(const GemmStage<MT, AL, BL>& st, bf16_t* sA, bf16_t* sB, int t, int kc, int bg, int bkg) {
#pragma unroll
  for (int i = 0; i < MT; ++i) *(u32x4*)(sA + ((t >> 3) + 32 * i) * 64 + ((kc ^ ((t >> 4) & 7)) * 8)) = st.ra[i];
  if constexpr (!BL::kDirect) {
#pragma unroll
    for (int i = 0; i < 4; ++i) {
      const int n = 4 * bg + i;
      u32x4 v;
      v.x = pack2(st.rbw[0][i], st.rbw[1][i]);
      v.y = pack2(st.rbw[2][i], st.rbw[3][i]);
      v.z = pack2(st.rbw[4][i], st.rbw[5][i]);
      v.w = pack2(st.rbw[6][i], st.rbw[7][i]);
      *(u32x4*)(sB + n * 64 + ((bkg ^ ((n >> 1) & 7)) * 8)) = v;
    }
  } else {
#pragma unroll
    for (int i = 0; i < 4; ++i) {
      const int n = (t >> 3) + 32 * i;
      *(u32x4*)(sB + n * 64 + ((kc ^ ((n >> 1) & 7)) * 8)) = st.rbd[i];
    }
  }
}

template <int MT>
__device__ __forceinline__ void gemm_compute(f32x4 (&acc)[MT][4], const bf16_t* sA, const bf16_t* sB, int wm, int wn, int c, int q) {
  const bf16_t* pa = sA + (wm * MT * 16 + c) * 64;
  const bf16_t* pb = sB + (wn * 64 + c) * 64;
  __builtin_amdgcn_s_setprio(1);
#pragma unroll
  for (int ks = 0; ks < 2; ++ks) {
    const int ko = ((ks * 4 + q) ^ (c >> 1)) * 8;
    bf16x8 bfr[4];
    bf16x8 afr[3];
#pragma unroll
    for (int nt = 0; nt < 4; ++nt) bfr[nt] = *(const bf16x8*)(pb + nt * 16 * 64 + ko);
    afr[0] = *(const bf16x8*)(pa + ko);
    if (MT > 1) afr[1] = *(const bf16x8*)(pa + 1 * 16 * 64 + ko);
    __builtin_amdgcn_sched_group_barrier(0x100, 6, 0);
#pragma unroll
    for (int mt = 0; mt < MT; ++mt) {
      if (mt + 2 < MT) afr[(mt + 2) % 3] = *(const bf16x8*)(pa + (mt + 2) * 16 * 64 + ko);
#pragma unroll
      for (int nt = 0; nt < 4; ++nt) acc[mt][nt] = MFMA16(afr[mt % 3], bfr[nt], acc[mt][nt]);
      if (mt + 2 < MT) __builtin_amdgcn_sched_group_barrier(0x100, 1, 0);
      __builtin_amdgcn_sched_group_barrier(0x008, 4, 0);
    }
  }
  __builtin_amdgcn_s_setprio(0);
}

template <int MT, int DEPTH, bool NOLOAD = false, class AL, class BL, class EP>
__device__ __forceinline__ void gemm_tile(char* smem, int K, const AL al, const BL bl, const EP ep) {
  constexpr int BM = MT * 32;
  bf16_t* sA = (bf16_t*)smem;
  bf16_t* sB = sA + BM * 64;
  const int t = tid(), lane = t & 63, w = t >> 6, wm = w >> 1, wn = w & 1;
  const int c = lane & 15, q = lane >> 4;
  f32x4 acc[MT][4];
#pragma unroll
  for (int i = 0; i < MT; ++i)
#pragma unroll
    for (int j = 0; j < 4; ++j) acc[i][j] = f32x4{0.f, 0.f, 0.f, 0.f};

  typename AL::RowH rh[MT];
#pragma unroll
  for (int i = 0; i < MT; ++i) rh[i] = al.row((t >> 3) + 32 * i);
  const int kc = t & 7;
  const int bg = t & 31, bkg = t >> 5;
  const float* bp = nullptr;
  const bf16_t* bdp[4] = {nullptr, nullptr, nullptr, nullptr};
  if constexpr (!BL::kDirect && BL::kUniform) {
    bp = (const float*)(uintptr_t)(uint32_t)(4 * bg + bkg * 8 * bl.ldb);
  } else if constexpr (!BL::kDirect) {
    bp = bl.colptr(4 * bg) + (size_t)(bkg * 8) * bl.ldb;
  } else {
#pragma unroll
    for (int i = 0; i < 4; ++i) bdp[i] = bl.rowptr((t >> 3) + 32 * i) + kc * 8;
  }
  GemmStage<MT, AL, BL> st[DEPTH];
#pragma unroll
  for (int d = 0; d < DEPTH; ++d) gemm_load<MT, AL, BL>(st[d], al, bl, rh, bp, bdp, kc, 64 * d);

  constexpr bool DB = (MT <= 4) && (DEPTH == 1) && !NOLOAD;
  if constexpr (DB) {
    constexpr int STG = (BM + 128) * 64;
    gemm_store<MT, AL, BL>(st[0], sA, sB, t, kc, bg, bkg);
    __syncthreads();
    if (64 < K) gemm_load<MT, AL, BL>(st[0], al, bl, rh, bp, bdp, kc, 64);
    int cur = 0;
    for (int k0 = 0; k0 < K; k0 += 64) {
      gemm_compute<MT>(acc, sA + cur * STG, sB + cur * STG, wm, wn, c, q);
      if (k0 + 64 < K) gemm_store<MT, AL, BL>(st[0], sA + (cur ^ 1) * STG, sB + (cur ^ 1) * STG, t, kc, bg, bkg);
      if (k0 + 128 < K) gemm_load<MT, AL, BL>(st[0], al, bl, rh, bp, bdp, kc, k0 + 128);
      __syncthreads();
      cur ^= 1;
    }
  } else
  for (int k0 = 0; k0 < K; k0 += 64 * DEPTH) {
#pragma unroll
    for (int d = 0; d < DEPTH; ++d) {
      gemm_store<MT, AL, BL>(st[d], sA, sB, t, kc, bg, bkg);
      const int kn = k0 + 64 * (d + DEPTH);
      if (!NOLOAD && kn < K) gemm_load<MT, AL, BL>(st[d], al, bl, rh, bp, bdp, kc, kn);
      __syncthreads();
#ifdef SCHED_BAR
      __builtin_amdgcn_sched_barrier(0);
#endif
      gemm_compute<MT>(acc, sA, sB, wm, wn, c, q);
#ifdef SCHED_BAR
      __builtin_amdgcn_sched_barrier(0);
#endif
      __syncthreads();
    }
  }
  ep(acc, wm, wn, lane);
}

struct EpStoreF32 {
  float* C; int ldc; int m0, n0;
  template <int MT>
  __device__ __forceinline__ void operator()(f32x4 (&acc)[MT][4], int wm, int wn, int lane) const {
    const int c = lane & 15, q = lane >> 4;
#pragma unroll
    for (int mt = 0; mt < MT; ++mt)
#pragma unroll
      for (int nt = 0; nt < 4; ++nt)
#pragma unroll
        for (int j = 0; j < 4; ++j) {
          int row = m0 + wm * MT * 16 + mt * 16 + 4 * q + j;
          int col = n0 + wn * 64 + nt * 16 + c;
          C[(size_t)row * ldc + col] = acc[mt][nt][j];
        }
  }
};
struct EpResidual {
  float* pre; const float* xin; const float* gate; int m0, n0;
  template <int MT>
  __device__ __forceinline__ void operator()(f32x4 (&acc)[MT][4], int wm, int wn, int lane) const {
    const int c = lane & 15, q = lane >> 4;
    float gv[4];
#pragma unroll
    for (int nt = 0; nt < 4; ++nt) gv[nt] = gate[n0 + wn * 64 + nt * 16 + c];
#pragma unroll
    for (int mt = 0; mt < MT; ++mt) {
#pragma unroll
      for (int j = 0; j < 4; ++j) {
        const uint32_t ro = (uint32_t)(wm * MT * 16 + mt * 16 + 4 * q + j) * DM + n0 + wn * 64 + c;
#pragma unroll
        for (int nt = 0; nt < 4; ++nt)
          pre[ro + nt * 16] = ALPHA_F * xin[ro + nt * 16] + gv[nt] * acc[mt][nt][j];
      }
      __builtin_amdgcn_sched_barrier(0);
    }
  }
};
struct EpDft {
  float* yfn; int tok0; int n0; float scale;
  template <int MT>
  __device__ __forceinline__ void operator()(f32x4 (&acc)[MT][4], int wm, int wn, int lane) const {
    const int c = lane & 15, q = lane >> 4;
#pragma unroll
    for (int mt = 0; mt < MT; ++mt)
#pragma unroll
      for (int nt = 0; nt < 4; ++nt)
#pragma unroll
        for (int j = 0; j < 4; ++j) {
          int row = tok0 + wm * MT * 16 + mt * 16 + 4 * q + j;
          int col = n0 + wn * 64 + nt * 16 + c;
          unsafeAtomicAdd(yfn + (size_t)row * 256 + col, acc[mt][nt][j] * scale);
        }
  }
};
struct EpGateUp {
  bf16_t* h; int m0, n0g;
  template <int MT>
  __device__ __forceinline__ void operator()(f32x4 (&acc)[MT][4], int wm, int wn, int lane) const {
    const int c = lane & 15, q = lane >> 4;
#pragma unroll
    for (int mt = 0; mt < MT; ++mt)
#pragma unroll
      for (int ntp = 0; ntp < 2; ++ntp)
#pragma unroll
        for (int j = 0; j < 4; ++j) {
          int row = m0 + wm * MT * 16 + mt * 16 + 4 * q + j;
          int col = n0g + wn * 32 + ntp * 16 + c;
          float g = acc[mt][ntp][j], u = acc[mt][ntp + 2][j];
          h[(size_t)row * 2048 + col] = (bf16_t)f2bf(siluf_(g) * u);
        }
  }
};
struct EpDown {
  float* ye; int m0, n0;
  template <int MT>
  __device__ __forceinline__ void operator()(f32x4 (&acc)[MT][4], int wm, int wn, int lane) const {
    const int c = lane & 15, q = lane >> 4;
#pragma unroll
    for (int mt = 0; mt < MT; ++mt)
#pragma unroll
      for (int j = 0; j < 4; ++j) {
        const uint32_t ro = (uint32_t)(m0 + wm * MT * 16 + mt * 16 + 4 * q + j) * 1024u + n0 + wn * 64 + c;
#pragma unroll
        for (int nt = 0; nt < 4; ++nt) ye[ro + nt * 16] = acc[mt][nt][j];
      }
  }
};
struct OddPtrs { bf16_t *swaQ, *swaK, *swaVt, *diffQ, *diffK, *diffVt; float* out; };
struct EpOddProj {
  OddPtrs p; int m0, n0;
  template <int MT>
  __device__ __forceinline__ void operator()(f32x4 (&acc)[MT][4], int wm, int wn, int lane) const {
    const int c = lane & 15, q = lane >> 4;
    const int hb = (n0 + wn * 64) >> 6;
    const bool latent = m0 >= NCTX;
    const bool roped = latent && (hb < 10 || (hb >= 12 && hb < 28));
    const float invf = exp2f(-(float)c * (13.287712379549449f / 16.0f));
#pragma unroll
    for (int mt = 0; mt < MT; ++mt) {
      const int tokb = m0 + wm * MT * 16 + mt * 16 + 4 * q;
      float v[4][4];
#pragma unroll
      for (int nt = 0; nt < 4; ++nt)
#pragma unroll
        for (int j = 0; j < 4; ++j) v[nt][j] = acc[mt][nt][j];
      if (roped) {
#pragma unroll
        for (int j = 0; j < 4; ++j) {
          const int s = (tokb + j - NCTX) & 2047;
          const float prow = (float)(s >> 6), pcol = (float)(s & 63);
          float ar = prow * invf * 0.15915494309189535f, ac = pcol * invf * 0.15915494309189535f;
          float cr = __builtin_amdgcn_cosf(ar - floorf(ar)), sr = __builtin_amdgcn_sinf(ar - floorf(ar));
          float cc = __builtin_amdgcn_cosf(ac - floorf(ac)), sc = __builtin_amdgcn_sinf(ac - floorf(ac));
          float a1 = v[0][j], a2 = v[1][j];
          v[0][j] = a1 * cr - a2 * sr; v[1][j] = a2 * cr + a1 * sr;
          float b1 = v[2][j], b2 = v[3][j];
          v[2][j] = b1 * cc - b2 * sc; v[3][j] = b2 * cc + b1 * sc;
        }
      }
      if (hb < 8) {
#pragma unroll
        for (int nt = 0; nt < 4; ++nt)
#pragma unroll
          for (int j = 0; j < 4; ++j)
            p.swaQ[(size_t)(tokb + j) * 512 + hb * 64 + nt * 16 + c] = (bf16_t)f2bf(v[nt][j] * 0.125f);
      } else if (hb < 10) {
        const int kvh = hb - 8;
#pragma unroll
        for (int nt = 0; nt < 4; ++nt)
#pragma unroll
          for (int j = 0; j < 4; ++j) {
            p.swaK[((size_t)kvh * NTOK + tokb + j) * 64 + nt * 16 + c] = (bf16_t)f2bf(v[nt][j]);
            if (!latent) p.out[8413184 + ((size_t)(tokb + j) * 2 + kvh) * 64 + nt * 16 + c] = v[nt][j];
          }
      } else if (hb < 12) {
        const int kvh = hb - 10;
#pragma unroll
        for (int nt = 0; nt < 4; ++nt) {
          uint2 pk; pk.x = pack2(v[nt][0], v[nt][1]); pk.y = pack2(v[nt][2], v[nt][3]);
          *(uint2*)(p.swaVt + ((size_t)kvh * 64 + nt * 16 + c) * NTOK + tokb) = pk;
          if (!latent) {
#pragma unroll
            for (int j = 0; j < 4; ++j) p.out[8937472 + ((size_t)(tokb + j) * 2 + kvh) * 64 + nt * 16 + c] = v[nt][j];
          }
        }
      } else if (hb < 20) {
#pragma unroll
        for (int nt = 0; nt < 4; ++nt)
#pragma unroll
          for (int j = 0; j < 4; ++j)
            p.diffQ[(size_t)(tokb + j) * 512 + (hb - 12) * 64 + nt * 16 + c] = (bf16_t)f2bf(v[nt][j] * 0.125f);
      } else if (hb < 28) {
        const int hh = (hb - 20) >> 1, mm = (hb - 20) & 1;
#pragma unroll
        for (int nt = 0; nt < 4; ++nt)
#pragma unroll
          for (int j = 0; j < 4; ++j) {
            p.diffK[((size_t)hh * NTOK + tokb + j) * 128 + mm * 64 + nt * 16 + c] = (bf16_t)f2bf(v[nt][j]);
            if (!latent) p.out[9461760 + (size_t)(tokb + j) * 512 + (hb - 20) * 64 + nt * 16 + c] = v[nt][j];
          }
      } else {
        const int hh = (hb - 28) >> 1, dvb = ((hb - 28) & 1) * 64;
#pragma unroll
        for (int nt = 0; nt < 4; ++nt) {
          uint2 pk; pk.x = pack2(v[nt][0], v[nt][1]); pk.y = pack2(v[nt][2], v[nt][3]);
          *(uint2*)(p.diffVt + ((size_t)hh * 128 + dvb + nt * 16 + c) * NTOK + tokb) = pk;
          if (!latent) {
#pragma unroll
            for (int j = 0; j < 4; ++j) p.out[11558912 + (size_t)(tokb + j) * 512 + (hb - 28) * 64 + nt * 16 + c] = v[nt][j];
          }
        }
      }
    }
  }
};

__device__ __forceinline__ void prep_item(const Params& p, char* smem, int it) {
  const int t = tid(), lane = t & 63, w = t >> 6;
  if (it < 768) {
    const int l = it / 384, r = it % 384, n0 = (r >> 4) * 256, ks = r & 15;
    float* sc = (float*)smem;
    float* red = sc + 192;
    if (t < 192) {
      int v = t >> 6, k = ks * 64 + (t & 63);
      float cv = v == 0 ? p.c_ctx[k] : p.c[(v - 1) * 1024 + k];
      sc[t] = siluf_(cv);
    }
    const float* wp = p.w_mod + ((size_t)l * 1024 + ks * 64 + w * 16) * 6144 + n0 + lane * 4;
    float4 wv[16];
#pragma unroll
    for (int k = 0; k < 16; ++k) wv[k] = *(const float4*)(wp + (size_t)k * 6144);
    __syncthreads();
    float4 a0 = make_float4(0.f, 0.f, 0.f, 0.f), a1 = a0, a2 = a0;
#pragma unroll
    for (int k = 0; k < 16; ++k) {
      const float s0 = sc[w * 16 + k], s1 = sc[64 + w * 16 + k], s2 = sc[128 + w * 16 + k];
      a0.x += s0 * wv[k].x; a0.y += s0 * wv[k].y; a0.z += s0 * wv[k].z; a0.w += s0 * wv[k].w;
      a1.x += s1 * wv[k].x; a1.y += s1 * wv[k].y; a1.z += s1 * wv[k].z; a1.w += s1 * wv[k].w;
      a2.x += s2 * wv[k].x; a2.y += s2 * wv[k].y; a2.z += s2 * wv[k].z; a2.w += s2 * wv[k].w;
    }
    *(float4*)(red + (w * 3 + 0) * 256 + lane * 4) = a0;
    *(float4*)(red + (w * 3 + 1) * 256 + lane * 4) = a1;
    *(float4*)(red + (w * 3 + 2) * 256 + lane * 4) = a2;
    __syncthreads();
#pragma unroll
    for (int v = 0; v < 3; ++v) {
      float sm = red[(0 * 3 + v) * 256 + t] + red[(1 * 3 + v) * 256 + t] + red[(2 * 3 + v) * 256 + t] + red[(3 * 3 + v) * 256 + t];
      if (ks == 0) sm += p.b_mod[l * 6144 + n0 + t];
      unsafeAtomicAdd(p.mod + ((size_t)l * 3 + v) * 6144 + n0 + t, sm);
    }
    __syncthreads();
  } else if (it < 896) {
    const int o = (it - 768) * 256 + t;
    const int g = o >> 13, rem = o & 8191, n = rem >> 6, cc = rem & 63;
    const bool sn = n >= 64; const int d = n & 63;
    float s = 0.f;
    for (int kc = 0; kc < 64; ++kc) {
      float x = (float)((cc * kc) & 63) * (1.0f / 64.0f);
      float tr = sn ? __builtin_amdgcn_sinf(x) : __builtin_amdgcn_cosf(x);
      s += tr * p.e_w_fnet[((size_t)g * 64 + kc) * 64 + d];
    }
    p.wcsT[o] = (bf16_t)f2bf(s * 0.125f);
  } else if (it < 3456) {
    int e = (it - 896) * 256 + t;
    if (e < 65536) {
      int d = e & 63, key = (e >> 6) & 255, h = (e >> 14) & 1, b = e >> 15;
      p.cswaK[e] = (bf16_t)f2bf(p.cache_swa_k[(((size_t)b * 256 + key) * 2 + h) * 64 + d]);
    } else if (e < 131072) {
      e -= 65536;
      int key = e & 255, d = (e >> 8) & 63, h = (e >> 14) & 1, b = e >> 15;
      p.cswaVt[e] = (bf16_t)f2bf(p.cache_swa_v[(((size_t)b * 256 + key) * 2 + h) * 64 + d]);
    } else if (e < 131072 + 262144) {
      e -= 131072;
      int md = e & 127, key = (e >> 7) & 255, h = (e >> 15) & 3, b = e >> 17;
      p.cdiffK[e] = (bf16_t)f2bf(p.cache_diff_k[(((size_t)b * 256 + key) * 4 + h) * 128 + md]);
    } else {
      e -= 131072 + 262144;
      int key = e & 255, dv = (e >> 8) & 127, h = (e >> 15) & 3, b = e >> 17;
      p.cdiffVt[e] = (bf16_t)f2bf(p.cache_diff_v[(((size_t)b * 256 + key) * 4 + h) * 128 + dv]);
    }
  } else if (it < 3456 + 128) {
    const int o = (it - 3456) * 256 + t;
    const int l = o >> 14, r = o & 16383, e = r >> 10, k = r & 1023;
    p.wrT[o] = p.w_router[(size_t)l * 16384 + k * 16 + e];
  } else {
    if (t < 4) {
      float s1 = 0.f, s2 = 0.f;
      for (int d = 0; d < 64; ++d) {
        s1 += p.o_lambda[(0 * 4 + t) * 64 + d] * p.o_lambda[(1 * 4 + t) * 64 + d];
        s2 += p.o_lambda[(2 * 4 + t) * 64 + d] * p.o_lambda[(3 * 4 + t) * 64 + d];
      }
      p.lam[t] = expf(s1) - expf(s2) + LAM_INIT;
    }
  }
}

__device__ __forceinline__ void u0_phase(const Params& p) {
  const int nchunk = NTOK * DM / 8;
  for (int ci = blockIdx.x * 256 + tid(); ci < nchunk; ci += gridDim.x * 256) {
    const int token = ci >> 7, k = (ci & 127) * 8;
    const float* xr = token < NCTX ? p.x_prompt + (size_t)token * DM : p.x_sample + (size_t)(token - NCTX) * DM;
    const float* md = p.mod + (size_t)vec_of_token(token) * 6144;
    float4 xa = *(const float4*)(xr + k), xb = *(const float4*)(xr + k + 4);
    float4 sa = *(const float4*)(md + k), sb = *(const float4*)(md + k + 4);
    float4 ca = *(const float4*)(md + 1024 + k), cb = *(const float4*)(md + 1024 + k + 4);
    uint4 r;
    r.x = pack2(xa.x * (1.f + ca.x) + sa.x, xa.y * (1.f + ca.y) + sa.y);
    r.y = pack2(xa.z * (1.f + ca.z) + sa.z, xa.w * (1.f + ca.w) + sa.w);
    r.z = pack2(xb.x * (1.f + cb.x) + sb.x, xb.y * (1.f + cb.y) + sb.y);
    r.w = pack2(xb.z * (1.f + cb.z) + sb.z, xb.w * (1.f + cb.w) + sb.w);
    *(uint4*)(p.ubuf + (size_t)token * DM + k) = r;
  }
}

__device__ __forceinline__ void scan_item(const Params& p, char* smem, int item, bool final_pass) {
  const int t = tid(), lane = t & 63, w = t >> 6, c = lane & 15, q = lane >> 4;
  const int chunk = item / 12, head = item % 12;
  const int t0 = chunk * 64;
  int sb, seq_start, seq_len;
  if (t0 < NCTX) { sb = t0 >> 8; seq_start = sb << 8; seq_len = 256; }
  else { int b = (t0 - NCTX) >> 11; sb = 16 + b; seq_start = NCTX + (b << 11); seq_len = 2048; }
  const int seq_end = seq_start + seq_len;
  float* xcf = (float*)smem;
  bf16_t* xcb = (bf16_t*)(smem + 16384);
  bf16_t* wb = (bf16_t*)(smem + 25600);
  float* seg = (float*)(smem + 25600);

  float hcarry = 0.f;
  if (final_pass && t < 128) {
    const int d2 = t >> 6, gch = head * 64 + (t & 63);
    if (sb >= 16) hcarry = p.state_rglru[((sb - 16) * 2 + d2) * 768 + gch];
    const int cfirst = seq_start >> 6, clast = (seq_end >> 6) - 1;
    if (d2 == 0) {
#pragma unroll 16
      for (int cp = cfirst; cp < chunk; ++cp)
        hcarry = p.sumA[((size_t)cp * 2 + 0) * 768 + gch] * hcarry + p.sumB[((size_t)cp * 2 + 0) * 768 + gch];
    } else {
#pragma unroll 16
      for (int cp = clast; cp > chunk; --cp)
        hcarry = p.sumA[((size_t)cp * 2 + 1) * 768 + gch] * hcarry + p.sumB[((size_t)cp * 2 + 1) * 768 + gch];
    }
  }
  f32x4 rv[2][8];
#pragma unroll
  for (int ii = 0; ii < 2; ++ii) {
    const int pi = t + 256 * ii;
    const int g = pi & 63, kg = pi >> 6;
    const int n4 = 4 * g;
    const int wv = n4 >> 6, within = n4 & 63;
    const int is_i = within >> 5, dcol = (wv & 1) * 32 + (within & 31), dirw = wv >> 1;
    const float* src = (is_i ? p.e_w_igate : p.e_w_rgate) + (((size_t)dirw * 12 + head) * 64 + kg * 8) * 64 + dcol;
#pragma unroll
    for (int j = 0; j < 8; ++j) rv[ii][j] = *(const f32x4*)(src + j * 64);
  }
  {
    const int cc = t & 63, gch = head * 64 + cc;
    const float w0 = p.e_conv_w[0 * 768 + gch], w1 = p.e_conv_w[1 * 768 + gch], w2 = p.e_conv_w[2 * 768 + gch], w3 = p.e_conv_w[3 * 768 + gch];
    const float cb = p.e_conv_b[gch];
    float xr[19];
    float xv[16][4];
#pragma unroll
    for (int i = 0; i < 16; ++i) {
      const int tk = t0 + (t >> 6) + 4 * i;
      const float* xp = p.proj0 + (size_t)tk * 1792 + gch;
      xv[i][0] = (tk - 1 >= seq_start) ? xp[-1792] : 0.f;
      xv[i][1] = xp[0];
      xv[i][2] = (tk + 1 < seq_end) ? xp[1792] : 0.f;
      xv[i][3] = (tk + 2 < seq_end) ? xp[2 * 1792] : 0.f;
    }
    (void)xr;
#pragma unroll
    for (int i = 0; i < 16; ++i) {
      const int r = (t >> 6) + 4 * i;
      float xc = cb + w0 * xv[i][0] + w1 * xv[i][1] + w2 * xv[i][2] + w3 * xv[i][3];
      xcf[r * 64 + cc] = xc;
      xcb[r * 72 + cc] = (bf16_t)f2bf(xc);
    }
  }
#pragma unroll
  for (int ii = 0; ii < 2; ++ii) {
    const int pi = t + 256 * ii;
    const int g = pi & 63, kg = pi >> 6;
    const int n4 = 4 * g;
#pragma unroll
    for (int i = 0; i < 4; ++i) {
      const int n = n4 + i;
      u32x4 v;
      v.x = pack2(rv[ii][0][i], rv[ii][1][i]);
      v.y = pack2(rv[ii][2][i], rv[ii][3][i]);
      v.z = pack2(rv[ii][4][i], rv[ii][5][i]);
      v.w = pack2(rv[ii][6][i], rv[ii][7][i]);
      *(u32x4*)(wb + n * 72 + ((kg ^ ((n >> 4) & 3)) * 8)) = v;
    }
  }
  __syncthreads();
  f32x4 acc[4][4];
#pragma unroll
  for (int i = 0; i < 4; ++i)
#pragma unroll
    for (int j = 0; j < 4; ++j) acc[i][j] = f32x4{0.f, 0.f, 0.f, 0.f};
#pragma unroll
  for (int ks = 0; ks < 2; ++ks) {
    bf16x8 bfr[4];
#pragma unroll
    for (int nt = 0; nt < 4; ++nt) bfr[nt] = *(const bf16x8*)(wb + (w * 64 + nt * 16 + c) * 72 + (((ks * 4 + q) ^ nt) * 8));
#pragma unroll
    for (int mt = 0; mt < 4; ++mt) {
      bf16x8 afr = *(const bf16x8*)(xcb + (mt * 16 + c) * 72 + (ks * 4 + q) * 8);
#pragma unroll
      for (int nt = 0; nt < 4; ++nt) acc[mt][nt] = MFMA16(afr, bfr[nt], acc[mt][nt]);
    }
  }
  __syncthreads();
  const int dir = w >> 1, halfc = w & 1;
  float av[4][2][4], bv[4][2][4];
#pragma unroll
  for (int ntp = 0; ntp < 2; ++ntp) {
    const int ch = halfc * 32 + ntp * 16 + c, gch = head * 64 + ch;
    const float br = p.e_b_rgate[dir * 768 + gch], bi = p.e_b_igate[dir * 768 + gch];
    const float lamv = p.e_lambda[dir * 768 + gch];
    const float sp = log1pf(expf(-lamv));
#pragma unroll
    for (int mt = 0; mt < 4; ++mt) {
#pragma unroll
      for (int j = 0; j < 4; ++j) {
        const int r = mt * 16 + 4 * q + j;
        float rg = sigmoidf_(acc[mt][ntp][j] + br);
        float ig = sigmoidf_(acc[mt][ntp + 2][j] + bi);
        float log_a = -8.0f * sp * rg;
        float a = __builtin_amdgcn_exp2f(log_a * 1.4426950408889634f);
        float bt = __builtin_amdgcn_sqrtf(fmaxf(1.0f - a * a, 0.f)) * ig * xcf[r * 64 + ch];
        av[mt][ntp][j] = a; bv[mt][ntp][j] = bt;
      }
      float A, B;
      if (dir == 0) {
        A = av[mt][ntp][0]; B = bv[mt][ntp][0];
#pragma unroll
        for (int j = 1; j < 4; ++j) { B = B * av[mt][ntp][j] + bv[mt][ntp][j]; A *= av[mt][ntp][j]; }
      } else {
        A = av[mt][ntp][3]; B = bv[mt][ntp][3];
#pragma unroll
        for (int j = 2; j >= 0; --j) { B = B * av[mt][ntp][j] + bv[mt][ntp][j]; A *= av[mt][ntp][j]; }
      }
      const int sidx = mt * 4 + q;
      *(float2*)(seg + ((dir * 16 + sidx) * 64 + ch) * 2) = make_float2(A, B);
    }
  }
  __syncthreads();
  float gav[4][2][4];
  if (final_pass && dir == 0) {
#pragma unroll
    for (int ntp = 0; ntp < 2; ++ntp)
#pragma unroll
      for (int mt = 0; mt < 4; ++mt)
#pragma unroll
        for (int j = 0; j < 4; ++j)
          gav[mt][ntp][j] = p.proj0[(size_t)(t0 + mt * 16 + 4 * q + j) * 1792 + 768 + head * 64 + halfc * 32 + ntp * 16 + c];
  }
  if (t < 128) {
    const int d2 = t >> 6, ch = t & 63, gch = head * 64 + ch;
    if (!final_pass) {
      float h = 0.f, Ap = 1.f;
      for (int ss = 0; ss < 16; ++ss) {
        const int s = d2 == 0 ? ss : 15 - ss;
        float2 ab = *(const float2*)(seg + ((d2 * 16 + s) * 64 + ch) * 2);
        h = ab.x * h + ab.y; Ap *= ab.x;
      }
      p.sumA[((size_t)chunk * 2 + d2) * 768 + gch] = Ap;
      p.sumB[((size_t)chunk * 2 + d2) * 768 + gch] = h;
    } else {
      float h = hcarry;
      const int cfirst = seq_start >> 6, clast = (seq_end >> 6) - 1;
      for (int ss = 0; ss < 16; ++ss) {
        const int s = d2 == 0 ? ss : 15 - ss;
        float* sp2 = seg + ((d2 * 16 + s) * 64 + ch) * 2;
        float2 ab = *(const float2*)sp2;
        sp2[0] = h;
        h = ab.x * h + ab.y;
      }
      if (sb < 16) {
        if (d2 == 0 && chunk == clast) p.out[8388608 + (sb * 2 + 0) * 768 + gch] = h;
        if (d2 == 1 && chunk == cfirst) p.out[8388608 + (sb * 2 + 1) * 768 + gch] = h;
      }
    }
  }
  __syncthreads();
  if (final_pass) {
    float hv[4][2][4];
#pragma unroll
    for (int ntp = 0; ntp < 2; ++ntp) {
      const int ch = halfc * 32 + ntp * 16 + c;
#pragma unroll
      for (int mt = 0; mt < 4; ++mt) {
        const int sidx = mt * 4 + q;
        float h = seg[((dir * 16 + sidx) * 64 + ch) * 2];
        if (dir == 0) {
#pragma unroll
          for (int j = 0; j < 4; ++j) { h = av[mt][ntp][j] * h + bv[mt][ntp][j]; hv[mt][ntp][j] = h; }
        } else {
#pragma unroll
          for (int j = 3; j >= 0; --j) { h = av[mt][ntp][j] * h + bv[mt][ntp][j]; hv[mt][ntp][j] = h; }
        }
      }
    }
    if (dir == 1) {
#pragma unroll
      for (int ntp = 0; ntp < 2; ++ntp)
#pragma unroll
        for (int mt = 0; mt < 4; ++mt)
#pragma unroll
          for (int j = 0; j < 4; ++j) xcf[(mt * 16 + 4 * q + j) * 64 + halfc * 32 + ntp * 16 + c] = hv[mt][ntp][j];
    }
    __syncthreads();
    if (dir == 0) {
#pragma unroll
      for (int ntp = 0; ntp < 2; ++ntp)
#pragma unroll
        for (int mt = 0; mt < 4; ++mt)
#pragma unroll
          for (int j = 0; j < 4; ++j) {
            const int r = mt * 16 + 4 * q + j, ch = halfc * 32 + ntp * 16 + c, gch = head * 64 + ch;
            const int tk = t0 + r;
            float ga = gav[mt][ntp][j];
            float y = (hv[mt][ntp][j] + xcf[r * 64 + ch]) * gelu_tanh(ga);
            p.mixed[(size_t)tk * DM + gch] = (bf16_t)f2bf(y);
          }
    }
    __syncthreads();
  }
}

__device__ __forceinline__ void fnet_tok_item(const Params& p, char* smem, int chunk) {
  const int t = tid(), lane = t & 63, w = t >> 6, c = lane & 15, q = lane >> 4;
  const int t0 = chunk * 64;
  int sb, seq_start, S;
  if (t0 < NCTX) { sb = t0 >> 8; seq_start = sb << 8; S = 256; }
  else { int b = (t0 - NCTX) >> 11; sb = 16 + b; seq_start = NCTX + (b << 11); S = 2048; }
  bf16_t* sA = (bf16_t*)smem;
  for (int ci = t; ci < 64 * 64; ci += 256) *(float4*)(p.yfn + (size_t)t0 * 256 + ci * 4) = make_float4(0.f, 0.f, 0.f, 0.f);
  for (int ci = t; ci < 64 * 32; ci += 256) {
    const int r = ci >> 5, k = (ci & 31) * 8;
    const float* xp = p.proj0 + (size_t)(t0 + r) * 1792 + 1536 + k;
    float4 a = *(const float4*)xp, b = *(const float4*)(xp + 4);
    uint4 v; v.x = pack2(a.x, a.y); v.y = pack2(a.z, a.w); v.z = pack2(b.x, b.y); v.w = pack2(b.z, b.w);
    *(uint4*)(sA + r * 264 + k) = v;
  }
  __syncthreads();
  const int g = w;
  bf16_t* ytb = p.YT + (sb < 16 ? (size_t)sb * 256 * 512 : (size_t)16 * 256 * 512 + (size_t)(sb - 16) * 256 * 4096);
  const int s0 = t0 - seq_start;
#pragma unroll
  for (int part = 0; part < 2; ++part) {
    f32x4 acc[4][4];
#pragma unroll
    for (int i = 0; i < 4; ++i)
#pragma unroll
      for (int j = 0; j < 4; ++j) acc[i][j] = f32x4{0.f, 0.f, 0.f, 0.f};
#pragma unroll
    for (int ks = 0; ks < 2; ++ks) {
      bf16x8 bfr[4];
#pragma unroll
      for (int nt = 0; nt < 4; ++nt)
        bfr[nt] = *(const bf16x8*)(p.wcsT + ((size_t)g * 128 + part * 64 + nt * 16 + c) * 64 + ks * 32 + q * 8);
#pragma unroll
      for (int mt = 0; mt < 4; ++mt) {
        bf16x8 afr = *(const bf16x8*)(sA + (mt * 16 + c) * 264 + g * 64 + ks * 32 + q * 8);
#pragma unroll
        for (int nt = 0; nt < 4; ++nt) acc[mt][nt] = MFMA16(afr, bfr[nt], acc[mt][nt]);
      }
    }
#pragma unroll
    for (int mt = 0; mt < 4; ++mt)
#pragma unroll
      for (int nt = 0; nt < 4; ++nt) {
        const int n = g * 64 + nt * 16 + c;
        uint2 pk; pk.x = pack2(acc[mt][nt][0], acc[mt][nt][1]); pk.y = pack2(acc[mt][nt][2], acc[mt][nt][3]);
        *(uint2*)(ytb + (size_t)n * (2 * S) + part * S + s0 + mt * 16 + 4 * q) = pk;
      }
  }
  __syncthreads();
}

__device__ __forceinline__ void ln_router_phase(const Params& p, char* smem, int l) {
  const int t = tid(), lane = t & 63, w = t >> 6;
  float* wT = (float*)smem;
  float4 vn[4];
  {
    const int tk0 = blockIdx.x * 4 + w;
    if (tk0 < NTOK) {
#pragma unroll
      for (int i = 0; i < 4; ++i) vn[i] = *(const float4*)(p.pre + (size_t)tk0 * DM + i * 256 + lane * 4);
    }
  }
  const float* wr = p.wrT + (size_t)l * 16384;
  for (int i = t; i < 4096; i += 256) *(float4*)(wT + i * 4) = *(const float4*)(wr + i * 4);
  __syncthreads();
  const float* g = p.ln_g + (l * 2 + 0) * 1024;
  const float* b = p.ln_b + (l * 2 + 0) * 1024;
  for (int token = blockIdx.x * 4 + w; token < NTOK; token += gridDim.x * 4) {
    const float* md = p.mod + ((size_t)l * 3 + vec_of_token(token)) * 6144;
    float4 v[4];
    float s = 0.f;
#pragma unroll
    for (int i = 0; i < 4; ++i) { v[i] = vn[i]; s += v[i].x + v[i].y + v[i].z + v[i].w; }
    {
      const int tkn = token + gridDim.x * 4;
      if (tkn < NTOK) {
#pragma unroll
        for (int i = 0; i < 4; ++i) vn[i] = *(const float4*)(p.pre + (size_t)tkn * DM + i * 256 + lane * 4);
      }
    }
    float s2 = 0.f;
#pragma unroll
    for (int i = 0; i < 4; ++i) s2 += v[i].x * v[i].x + v[i].y * v[i].y + v[i].z * v[i].z + v[i].w * v[i].w;
    wave_sum2(s, s2);
    const float mean = s * (1.0f / 1024.0f);
    const float rstd = rsqrtf(fmaxf(s2 * (1.0f / 1024.0f) - mean * mean, 0.f) + 1e-5f);
    float4 tkv[4];
#pragma unroll
    for (int i = 0; i < 4; ++i) {
      const int k = i * 256 + lane * 4;
      float4 gg = *(const float4*)(g + k), bb = *(const float4*)(b + k);
      float4 x;
      x.x = (v[i].x - mean) * rstd * gg.x + bb.x; x.y = (v[i].y - mean) * rstd * gg.y + bb.y;
      x.z = (v[i].z - mean) * rstd * gg.z + bb.z; x.w = (v[i].w - mean) * rstd * gg.w + bb.w;
      float4 sf = *(const float4*)(md + 3072 + k), cf = *(const float4*)(md + 4096 + k);
      float4 tk;
      tk.x = x.x * (1.f + cf.x) + sf.x; tk.y = x.y * (1.f + cf.y) + sf.y;
      tk.z = x.z * (1.f + cf.z) + sf.z; tk.w = x.w * (1.f + cf.w) + sf.w;
      uint2 pk; pk.x = pack2(tk.x, tk.y); pk.y = pack2(tk.z, tk.w);
      *(uint2*)(p.tok + (size_t)token * DM + k) = pk;
      tkv[i] = tk;
    }
    float pe[16];
#pragma unroll
    for (int e = 0; e < 16; ++e) {
      float sacc = 0.f;
#pragma unroll
      for (int i = 0; i < 4; ++i) {
        float4 wv = *(const float4*)(wT + e * 1024 + i * 256 + lane * 4);
        sacc += tkv[i].x * wv.x + tkv[i].y * wv.y + tkv[i].z * wv.z + tkv[i].w * wv.w;
      }
      pe[e] = sacc;
      if ((e & 1) == 1) __builtin_amdgcn_sched_barrier(0);
    }
    const bool b5 = (lane & 32) != 0, b4 = (lane & 16) != 0, b3 = (lane & 8) != 0, b2 = (lane & 4) != 0;
    float r8[8], r4[4], r2[2];
#pragma unroll
    for (int i = 0; i < 8; ++i) { float keep = b5 ? pe[i + 8] : pe[i]; float send = b5 ? pe[i] : pe[i + 8]; r8[i] = keep + x32_partner(send, b5); }
#pragma unroll
    for (int i = 0; i < 4; ++i) { float keep = b4 ? r8[i + 4] : r8[i]; float send = b4 ? r8[i] : r8[i + 4]; r4[i] = keep + x16_partner(send, b4); }
#pragma unroll
    for (int i = 0; i < 2; ++i) { float keep = b3 ? r4[i + 2] : r4[i]; float send = b3 ? r4[i] : r4[i + 2]; r2[i] = keep + __shfl_xor(send, 8); }
    float mine;
    { float keep = b2 ? r2[1] : r2[0]; float send = b2 ? r2[0] : r2[1]; mine = keep + __shfl_xor(send, 4); }
    mine += __shfl_xor(mine, 2);
    mine += __shfl_xor(mine, 1);
    float mx = mine;
#pragma unroll
    for (int o = 8; o >= 4; o >>= 1) mx = fmaxf(mx, __shfl_xor(mx, o));
    mx = x32_max(x16_max(mx));
    float ex = expf(mine - mx);
    float den = ex;
#pragma unroll
    for (int o = 8; o >= 4; o >>= 1) den += __shfl_xor(den, o);
    den = x32_sum(x16_sum(den));
    mine = ex / den;
    if ((lane & 3) == 0) p.aff[(size_t)token * 16 + (lane >> 2)] = mine;
    if (lane == 1) p.tcount[token] = 0;
  }
  __syncthreads();
}

__device__ __forceinline__ void topk_item(const Params& p, char* smem, int item) {
  const int t = tid(), lane = t & 63, w = t >> 6;
  const int group = item >> 4, e = item & 15;
  int* wsum = (int*)smem;
  int* cnts = wsum + 8;
  uint32_t v[16];
#pragma unroll
  for (int i = 0; i < 16; ++i) v[i] = __float_as_uint(p.aff[((size_t)group * 4096 + t + 256 * i) * 16 + e]);
  if (t == 0) { cnts[0] = 0; cnts[1] = 0; }
  uint32_t prefix = 0;
  int par = 0;
  for (int bit = 30; bit >= 0; --bit) {
    const uint32_t cand = prefix | (1u << bit);
    int cnt = 0;
#pragma unroll
    for (int i = 0; i < 16; ++i) cnt += (v[i] >= cand) ? 1 : 0;
    cnt = wave_sum_i(cnt);
    if (lane == 0) wsum[par * 4 + w] = cnt;
    __syncthreads();
    const int tot = wsum[par * 4 + 0] + wsum[par * 4 + 1] + wsum[par * 4 + 2] + wsum[par * 4 + 3];
    if (tot >= 512) prefix = cand;
    par ^= 1;
  }
  int cnt = 0;
#pragma unroll
  for (int i = 0; i < 16; ++i) cnt += (v[i] > prefix) ? 1 : 0;
  cnt = wave_sum_i(cnt);
  if (lane == 0) wsum[par * 4 + w] = cnt;
  __syncthreads();
  const int cgt = wsum[par * 4 + 0] + wsum[par * 4 + 1] + wsum[par * 4 + 2] + wsum[par * 4 + 3];
  const int need = 512 - cgt;
  int* oi = p.idx + e * 1024 + group * 512;
  float* og = p.gsel + e * 1024 + group * 512;
#pragma unroll
  for (int i = 0; i < 16; ++i) {
    const int tk = group * 4096 + t + 256 * i;
    if (v[i] > prefix) {
      int slot = atomicAdd(&cnts[0], 1);
      oi[slot] = tk; og[slot] = __uint_as_float(v[i]);
      int jj = atomicAdd(&p.tcount[tk], 1);
      p.tlist[tk * 16 + jj] = e * 1024 + group * 512 + slot;
    } else if (v[i] == prefix) {
      int k = atomicAdd(&cnts[1], 1);
      if (k < need) {
        oi[cgt + k] = tk; og[cgt + k] = __uint_as_float(v[i]);
        int jj = atomicAdd(&p.tcount[tk], 1);
        p.tlist[tk * 16 + jj] = e * 1024 + group * 512 + cgt + k;
      }
    }
  }
  __syncthreads();
}

__device__ __forceinline__ void final_ln_phase(const Params& p, int l) {
  const int t = tid(), lane = t & 63, w = t >> 6;
  const float* g = p.ln_g + (l * 2 + 1) * 1024;
  const float* b = p.ln_b + (l * 2 + 1) * 1024;
  float4 xn[4];
  int cntn = 0, listn = 0;
  {
    const int tk0 = blockIdx.x * 4 + w;
    if (tk0 < NTOK) {
#pragma unroll
      for (int i = 0; i < 4; ++i) xn[i] = *(const float4*)(p.pre + (size_t)tk0 * DM + i * 256 + lane * 4);
      cntn = p.tcount[tk0];
      listn = p.tlist[tk0 * 16 + (lane & 15)];
    }
  }
  for (int token = blockIdx.x * 4 + w; token < NTOK; token += gridDim.x * 4) {
    const int vec = vec_of_token(token);
    const float* md = p.mod + ((size_t)l * 3 + vec) * 6144;
    float4 v[4];
    float4 xc[4], fc[4];
    const int cnt = cntn, mylist = listn;
#pragma unroll
    for (int i = 0; i < 4; ++i) { xc[i] = xn[i]; fc[i] = make_float4(0.f, 0.f, 0.f, 0.f); }
    {
      float s0 = 0.f;
#pragma unroll
      for (int i = 0; i < 4; ++i) s0 += xc[i].x + xc[i].y + xc[i].z + xc[i].w;
      float q0 = 0.f;
#pragma unroll
      for (int i = 0; i < 4; ++i) q0 += xc[i].x * xc[i].x + xc[i].y * xc[i].y + xc[i].z * xc[i].z + xc[i].w * xc[i].w;
      wave_sum2(s0, q0);
      const float mean0 = s0 * (1.0f / 1024.0f);
      const float rstd0 = rsqrtf(fmaxf(q0 * (1.0f / 1024.0f) - mean0 * mean0, 0.f) + 1e-5f);
      const float* g0 = p.ln_g + (l * 2 + 0) * 1024;
      const float* b0 = p.ln_b + (l * 2 + 0) * 1024;
#pragma unroll
      for (int i = 0; i < 4; ++i) {
        const int k = i * 256 + lane * 4;
        float4 gg = *(const float4*)(g0 + k), bb = *(const float4*)(b0 + k);
        xc[i].x = (xc[i].x - mean0) * rstd0 * gg.x + bb.x; xc[i].y = (xc[i].y - mean0) * rstd0 * gg.y + bb.y;
        xc[i].z = (xc[i].z - mean0) * rstd0 * gg.z + bb.z; xc[i].w = (xc[i].w - mean0) * rstd0 * gg.w + bb.w;
      }
    }
    {
      const int tkn = token + gridDim.x * 4;
      if (tkn < NTOK) {
#pragma unroll
        for (int i = 0; i < 4; ++i) xn[i] = *(const float4*)(p.pre + (size_t)tkn * DM + i * 256 + lane * 4);
        cntn = p.tcount[tkn];
        listn = p.tlist[tkn * 16 + (lane & 15)];
      }
    }
    for (int j = 0; j < cnt; j += 2) {
      const int id0 = __shfl(mylist, j);
      const bool has1 = (j + 1) < cnt;
      const int id1 = has1 ? __shfl(mylist, (j + 1) & 15) : id0;
      const float g0 = p.gsel[id0];
      const float g1 = has1 ? p.gsel[id1] : 0.f;
      float4 y0[4], y1[4];
#pragma unroll
      for (int i = 0; i < 4; ++i) {
        y0[i] = *(const float4*)(p.ye + (size_t)id0 * DM + i * 256 + lane * 4);
        y1[i] = *(const float4*)(p.ye + (size_t)id1 * DM + i * 256 + lane * 4);
      }
#pragma unroll
      for (int i = 0; i < 4; ++i) {
        fc[i].x += g0 * y0[i].x + g1 * y1[i].x; fc[i].y += g0 * y0[i].y + g1 * y1[i].y;
        fc[i].z += g0 * y0[i].z + g1 * y1[i].z; fc[i].w += g0 * y0[i].w + g1 * y1[i].w;
      }
    }
    float s = 0.f;
#pragma unroll
    for (int i = 0; i < 4; ++i) {
      const int k = i * 256 + lane * 4;
      float4 x = xc[i];
      float4 f = fc[i];
      float4 gf = *(const float4*)(md + 5120 + k);
      v[i].x = ALPHA_F * x.x + gf.x * f.x; v[i].y = ALPHA_F * x.y + gf.y * f.y;
      v[i].z = ALPHA_F * x.z + gf.z * f.z; v[i].w = ALPHA_F * x.w + gf.w * f.w;
      s += v[i].x + v[i].y + v[i].z + v[i].w;
    }
    float s2 = 0.f;
#pragma unroll
    for (int i = 0; i < 4; ++i) s2 += v[i].x * v[i].x + v[i].y * v[i].y + v[i].z * v[i].z + v[i].w * v[i].w;
    wave_sum2(s, s2);
    const float mean = s * (1.0f / 1024.0f);
    const float rstd = rsqrtf(fmaxf(s2 * (1.0f / 1024.0f) - mean * mean, 0.f) + 1e-5f);
    const float* md1 = p.mod + ((size_t)1 * 3 + vec) * 6144;
#pragma unroll
    for (int i = 0; i < 4; ++i) {
      const int k = i * 256 + lane * 4;
      float4 gg = *(const float4*)(g + k), bb = *(const float4*)(b + k);
      float4 x;
      x.x = (v[i].x - mean) * rstd * gg.x + bb.x; x.y = (v[i].y - mean) * rstd * gg.y + bb.y;
      x.z = (v[i].z - mean) * rstd * gg.z + bb.z; x.w = (v[i].w - mean) * rstd * gg.w + bb.w;
      if (l == 0) {
        *(float4*)(p.x2 + (size_t)token * DM + k) = x;
        float4 sa = *(const float4*)(md1 + k), ca = *(const float4*)(md1 + 1024 + k);
        uint2 pk;
        pk.x = pack2(x.x * (1.f + ca.x) + sa.x, x.y * (1.f + ca.y) + sa.y);
        pk.y = pack2(x.z * (1.f + ca.z) + sa.z, x.w * (1.f + ca.w) + sa.w);
        *(uint2*)(p.ubuf + (size_t)token * DM + k) = pk;
      } else {
        *(float4*)(p.out + (size_t)token * DM + k) = x;
      }
    }
  }
}

template <bool DIFF>
__device__ __forceinline__ void attn_item(const Params& p, char* smem, int sb, int head, int qt) {
  constexpr int DV = DIFF ? 128 : 64;
  constexpr int KW = DIFF ? 128 : 64;
  constexpr int KS = KW + 8;
  constexpr int NH = DIFF ? 4 : 2;
  const int t = tid(), lane = t & 63, w = t >> 6, c = lane & 15, q = lane >> 4;
  bf16_t* sK = (bf16_t*)smem;
  bf16_t* sV = (bf16_t*)(smem + 17408);
  const bool latent = sb >= 16;
  const int seq_start = latent ? NCTX + ((sb - 16) << 11) : (sb << 8);
  int qrow0, koff;
  const bf16_t* qbase;
  if (!DIFF) { qrow0 = qt * 32; koff = 0; qbase = p.swaQ + (head * 4 + w) * 64; }
  else { qrow0 = qt * 64 + (w >> 1) * 32; koff = (w & 1) * 64; qbase = p.diffQ + (head * 2 + (w & 1)) * 64; }
  bf16x8 qf[2][2];
#pragma unroll
  for (int nt = 0; nt < 2; ++nt)
#pragma unroll
    for (int ks = 0; ks < 2; ++ks)
      qf[nt][ks] = *(const bf16x8*)(qbase + (size_t)(seq_start + qrow0 + nt * 16 + c) * 512 + ks * 32 + q * 8);
  float m_[2], l_[2];
  f32x4 accO[DV / 16][2];
#pragma unroll
  for (int i = 0; i < DV / 16; ++i) { accO[i][0] = f32x4{0.f, 0.f, 0.f, 0.f}; accO[i][1] = f32x4{0.f, 0.f, 0.f, 0.f}; }
  if (!DIFF) { float sk = p.o_sink[head * 4 + w]; m_[0] = m_[1] = sk; l_[0] = l_[1] = (q == 0) ? 1.f : 0.f; }
  else { m_[0] = m_[1] = -1e30f; l_[0] = l_[1] = 0.f; }

  const bf16_t* Ksrc = (DIFF ? p.diffK : p.swaK) + (size_t)head * NTOK * KW;
  const bf16_t* Vsrc = (DIFF ? p.diffVt : p.swaVt) + (size_t)head * DV * NTOK;
  const bf16_t* cK = nullptr; const bf16_t* cV = nullptr;
  int ntiles, tlo = 0;
  if (!latent) ntiles = 4;
  else {
    const int b = sb - 16;
    cK = (DIFF ? p.cdiffK : p.cswaK) + (size_t)(b * NH + head) * 256 * KW;
    cV = (DIFF ? p.cdiffVt : p.cswaVt) + (size_t)(b * NH + head) * DV * 256;
    if (DIFF) ntiles = 4 + 32;
    else {
      int lo = qrow0 - 128; if (lo < 0) lo = 0;
      int hi = qrow0 + 31 + 128; if (hi > 2047) hi = 2047;
      tlo = lo >> 6;
      ntiles = 4 + ((hi >> 6) - tlo + 1);
    }
  }
  auto tile_ptrs = [&](int ti, const bf16_t*& kp, const bf16_t*& vp, int& vstride) {
    if (!latent) { kp = Ksrc + (size_t)(seq_start + 64 * ti) * KW; vp = Vsrc + seq_start + 64 * ti; vstride = NTOK; }
    else if (ti < 4) { kp = cK + (size_t)(64 * ti) * KW; vp = cV + 64 * ti; vstride = 256; }
    else { const int kt = tlo + ti - 4; kp = Ksrc + (size_t)(seq_start + 64 * kt) * KW; vp = Vsrc + seq_start + 64 * kt; vstride = NTOK; }
  };
  u32x4 rk[KW / 32], rvv[DV / 32];
  {
    const bf16_t* kp; const bf16_t* vp; int vstride;
    tile_ptrs(0, kp, vp, vstride);
#pragma unroll
    for (int i = 0; i < KW / 32; ++i) { const int ci = t + 256 * i; rk[i] = *(const u32x4*)(kp + (size_t)(ci / (KW / 8)) * KW + (ci % (KW / 8)) * 8); }
#pragma unroll
    for (int i = 0; i < DV / 32; ++i) { const int ci = t + 256 * i; rvv[i] = *(const u32x4*)(vp + (size_t)(ci >> 3) * vstride + (ci & 7) * 8); }
  }
  for (int ti = 0; ti < ntiles; ++ti) {
    bool masked = false; int kpos0 = 0;
    if (latent && ti >= 4) { masked = !DIFF; kpos0 = 64 * (tlo + ti - 4); }
#pragma unroll
    for (int i = 0; i < KW / 32; ++i) { const int ci = t + 256 * i; *(u32x4*)(sK + (ci / (KW / 8)) * KS + (ci % (KW / 8)) * 8) = rk[i]; }
#pragma unroll
    for (int i = 0; i < DV / 32; ++i) { const int ci = t + 256 * i; *(u32x4*)(sV + (ci >> 3) * 72 + (ci & 7) * 8) = rvv[i]; }
    __syncthreads();
    if (ti + 1 < ntiles) {
      const bf16_t* kp; const bf16_t* vp; int vstride;
      tile_ptrs(ti + 1, kp, vp, vstride);
#pragma unroll
      for (int i = 0; i < KW / 32; ++i) { const int ci = t + 256 * i; rk[i] = *(const u32x4*)(kp + (size_t)(ci / (KW / 8)) * KW + (ci % (KW / 8)) * 8); }
#pragma unroll
      for (int i = 0; i < DV / 32; ++i) { const int ci = t + 256 * i; rvv[i] = *(const u32x4*)(vp + (size_t)(ci >> 3) * vstride + (ci & 7) * 8); }
    }
    f32x4 s[4][2];
#pragma unroll
    for (int mt = 0; mt < 4; ++mt) { s[mt][0] = f32x4{0.f, 0.f, 0.f, 0.f}; s[mt][1] = f32x4{0.f, 0.f, 0.f, 0.f}; }
#pragma unroll
    for (int ks = 0; ks < 2; ++ks)
#pragma unroll
      for (int mt = 0; mt < 4; ++mt) {
        bf16x8 kf = *(const bf16x8*)(sK + (mt * 16 + c) * KS + koff + ks * 32 + q * 8);
        s[mt][0] = MFMA16(kf, qf[0][ks], s[mt][0]);
        s[mt][1] = MFMA16(kf, qf[1][ks], s[mt][1]);
      }
    __builtin_amdgcn_sched_barrier(0);
    bf16x8 pf[2][2];
#pragma unroll
    for (int nt = 0; nt < 2; ++nt) {
      if (masked) {
        const int qpos = qrow0 + nt * 16 + c;
#pragma unroll
        for (int mt = 0; mt < 4; ++mt)
#pragma unroll
          for (int j = 0; j < 4; ++j) {
            int d = qpos - (kpos0 + mt * 16 + 4 * q + j);
            if (d > 128 || d < -128) s[mt][nt][j] = -1e30f;
          }
      }
      float mx = -1e30f;
#pragma unroll
      for (int mt = 0; mt < 4; ++mt)
#pragma unroll
        for (int j = 0; j < 4; ++j) mx = fmaxf(mx, s[mt][nt][j]);
      mx = x32_max(x16_max(mx));
      const float mnew = fmaxf(m_[nt], mx);
      const float alpha = __expf(m_[nt] - mnew);
      m_[nt] = mnew;
      float ps = 0.f;
      float pv[4][4];
#pragma unroll
      for (int mt = 0; mt < 4; ++mt)
#pragma unroll
        for (int j = 0; j < 4; ++j) { pv[mt][j] = __expf(s[mt][nt][j] - mnew); ps += pv[mt][j]; }
      l_[nt] = l_[nt] * alpha + ps;
#pragma unroll
      for (int i = 0; i < DV / 16; ++i) { accO[i][nt][0] *= alpha; accO[i][nt][1] *= alpha; accO[i][nt][2] *= alpha; accO[i][nt][3] *= alpha; }
#pragma unroll
      for (int s2 = 0; s2 < 2; ++s2) {
        uint4 u;
        u.x = pack2(pv[2 * s2][0], pv[2 * s2][1]); u.y = pack2(pv[2 * s2][2], pv[2 * s2][3]);
        u.z = pack2(pv[2 * s2 + 1][0], pv[2 * s2 + 1][1]); u.w = pack2(pv[2 * s2 + 1][2], pv[2 * s2 + 1][3]);
        pf[nt][s2] = *(bf16x8*)&u;
      }
    }
    __builtin_amdgcn_sched_barrier(0);
#pragma unroll
    for (int s2 = 0; s2 < 2; ++s2)
#pragma unroll
      for (int dvt = 0; dvt < DV / 16; ++dvt) {
        const bf16_t* vr = sV + (dvt * 16 + c) * 72 + 32 * s2 + 4 * q;
        uint2 lo = *(const uint2*)vr, hi = *(const uint2*)(vr + 16);
        uint4 u; u.x = lo.x; u.y = lo.y; u.z = hi.x; u.w = hi.y;
        bf16x8 vf = *(bf16x8*)&u;
        accO[dvt][0] = MFMA16(vf, pf[0][s2], accO[dvt][0]);
        accO[dvt][1] = MFMA16(vf, pf[1][s2], accO[dvt][1]);
      }
    __syncthreads();
  }
  float inv[2];
#pragma unroll
  for (int nt = 0; nt < 2; ++nt) {
    float lt = l_[nt];
    lt = x32_sum(x16_sum(lt));
    inv[nt] = 1.0f / lt;
  }
  if (!DIFF) {
#pragma unroll
    for (int nt = 0; nt < 2; ++nt) {
      const int token = seq_start + qrow0 + nt * 16 + c;
#pragma unroll
      for (int dvt = 0; dvt < DV / 16; ++dvt) {
        uint2 pk;
        pk.x = pack2(accO[dvt][nt][0] * inv[nt], accO[dvt][nt][1] * inv[nt]);
        pk.y = pack2(accO[dvt][nt][2] * inv[nt], accO[dvt][nt][3] * inv[nt]);
        *(uint2*)(p.mixed + (size_t)token * DM + (head * 4 + w) * 64 + dvt * 16 + 4 * q) = pk;
      }
    }
  } else {
    float* sX = (float*)smem;
    const int sub = w >> 1;
    const float lamh = p.lam[head];
    if (w & 1) {
#pragma unroll
      for (int dvt = 0; dvt < DV / 16; ++dvt)
#pragma unroll
        for (int nt = 0; nt < 2; ++nt)
#pragma unroll
          for (int j = 0; j < 4; ++j) sX[((((dvt * 2 + nt) * 4 + j) * 2 + sub) << 6) + lane] = accO[dvt][nt][j] * inv[nt] * lamh;
    }
    __syncthreads();
    if (!(w & 1)) {
#pragma unroll
      for (int nt = 0; nt < 2; ++nt) {
        float ss = 0.f;
#pragma unroll
        for (int dvt = 0; dvt < DV / 16; ++dvt)
#pragma unroll
          for (int j = 0; j < 4; ++j) {
            float y = accO[dvt][nt][j] * inv[nt] - sX[((((dvt * 2 + nt) * 4 + j) * 2 + sub) << 6) + lane];
            accO[dvt][nt][j] = y; ss += y * y;
          }
        ss = x32_sum(x16_sum(ss));
        const float rs = rsqrtf(ss * (1.0f / 128.0f) + 1e-5f) * (1.0f - LAM_INIT);
        const int token = seq_start + qrow0 + nt * 16 + c;
#pragma unroll
        for (int dvt = 0; dvt < DV / 16; ++dvt) {
          const int dv = dvt * 16 + 4 * q;
          float4 gg = *(const float4*)(p.o_subln_g + dv);
          uint2 pk;
          pk.x = pack2(accO[dvt][nt][0] * rs * gg.x, accO[dvt][nt][1] * rs * gg.y);
          pk.y = pack2(accO[dvt][nt][2] * rs * gg.z, accO[dvt][nt][3] * rs * gg.w);
          *(uint2*)(p.mixed + (size_t)token * DM + 512 + head * 128 + dv) = pk;
        }
      }
    }
    __syncthreads();
  }
}


#define XB_TMO      128
#define XB_XCNT(j)  (256  + 64 * (j))
#define XB_XSUB(j)  (1280 + 64 * (j))
#define XB_XGEN(j)  (2304 + 64 * (j))
#define XB_TOP      3328
#define XB_TOPGEN   3392
#define XCD_BAR_WORDS 3456
#define XB_SPIN_CAP (1u << 22)
#define LAS __attribute__((address_space(3)))
__device__ __forceinline__ unsigned xb_ld(unsigned* p) { return __hip_atomic_load(p, __ATOMIC_RELAXED, __HIP_MEMORY_SCOPE_AGENT); }
__device__ __forceinline__ unsigned xb_add(unsigned* p, unsigned v) { return __hip_atomic_fetch_add(p, v, __ATOMIC_RELAXED, __HIP_MEMORY_SCOPE_AGENT); }
__device__ __forceinline__ unsigned xb_xcc_id() { return (unsigned)__builtin_amdgcn_s_getreg((3 << 11) | 20) & 0xFu; }
#define XB_SPIN(cond, bar) do { unsigned _sp = 0; while (cond) { __builtin_amdgcn_s_sleep(1); \
    if ((++_sp & 255u) == 0u) { if (xb_ld(&(bar)[XB_TMO])) break; if (_sp > XB_SPIN_CAP) { atomicAdd(&(bar)[XB_TMO], 1u); break; } } } } while (0)
struct XcdBarrier { unsigned* bar; unsigned x; volatile LAS unsigned* st; };
__device__ __forceinline__ XcdBarrier xcd_barrier_post(unsigned* bar, volatile LAS unsigned* st) {
  XcdBarrier b; b.bar = bar; b.x = xb_xcc_id(); b.st = st;
  if (threadIdx.x == 0) (void)xb_add(&bar[XB_XCNT(b.x)], 1u);
  return b;
}
__device__ __forceinline__ void xcd_barrier_complete(unsigned* bar, unsigned x, unsigned& nloc, unsigned& nx) {
  const unsigned G = gridDim.x * gridDim.y * gridDim.z;
  unsigned sum, cnt, mine, sp = 0u;
  for (;;) {
    sum = 0u; cnt = 0u; mine = 0u;
#pragma unroll
    for (unsigned j = 0; j < 16; ++j) { const unsigned c = xb_ld(&bar[XB_XCNT(j)]); sum += c; cnt += (c > 0u) ? 1u : 0u; mine = (j == x) ? c : mine; }
    if (sum == G) break;
    __builtin_amdgcn_s_sleep(1);
    if ((++sp & 255u) == 0u) { if (xb_ld(&bar[XB_TMO])) break; if (sp > XB_SPIN_CAP) { atomicAdd(&bar[XB_TMO], 1u); break; } }
  }
  nloc = mine > 0u ? mine : 1u; nx = cnt > 0u ? cnt : 1u;
}
__device__ __forceinline__ void xcd_barrier(const XcdBarrier& b) {
  asm volatile("s_waitcnt vmcnt(0)" ::: "memory");
  __syncthreads();
  if (threadIdx.x == 0) {
    unsigned* bar = b.bar;
    __builtin_amdgcn_s_waitcnt(0);
    unsigned nloc = b.st[0], nx = b.st[1];
    if (nloc == 0u) { xcd_barrier_complete(bar, b.x, nloc, nx); b.st[0] = nloc; b.st[1] = nx; }
    const unsigned old = xb_add(&bar[XB_XSUB(b.x)], 1u);
    const unsigned gen = old / nloc;
    if (old + 1u == (gen + 1u) * nloc) {
      __builtin_amdgcn_fence(__ATOMIC_RELEASE, "agent");
      asm volatile("s_waitcnt vmcnt(0)" ::: "memory");
      const unsigned og = xb_add(&bar[XB_TOP], 1u);
      const unsigned tg = og / nx;
      if (og + 1u == (tg + 1u) * nx) xb_add(&bar[XB_TOPGEN], 1u);
      else XB_SPIN(xb_ld(&bar[XB_TOPGEN]) == tg, bar);
      __builtin_amdgcn_fence(__ATOMIC_ACQUIRE, "agent");
      xb_add(&bar[XB_XGEN(b.x)], 1u);
      asm volatile("s_waitcnt vmcnt(0)" ::: "memory");
    } else {
      XB_SPIN(xb_ld(&bar[XB_XGEN(b.x)]) == gen, bar);
      __builtin_amdgcn_fence(__ATOMIC_ACQUIRE, "agent");
      asm volatile("s_waitcnt vmcnt(0)" ::: "memory");
    }
  }
  __syncthreads();
}

#define NPHASE 19
constexpr int PBM = PROJ_MT * 32, PNM = NTOK / PBM;
template <int ph, bool PROBE = false>
__device__ __forceinline__ void run_phase(const Params& p, char* smem) {
  const int nb = gridDim.x, bid = blockIdx.x;
  const int vb = (bid & 7) * (nb >> 3) + (bid >> 3);
  switch (ph) {
    case 0:
      for (int it = bid; it < 3457 + 128; it += nb) prep_item(p, smem, it);
      break;
    case 1:
      u0_phase(p);
      break;
    case 2:
      for (int it = bid; it < PNM * 14; it += nb) {
        const int mt = it % PNM, nt = it / PNM;
        ADirect al{p.ubuf + (size_t)mt * PBM * DM, DM};
        BWeight bl{p.e_w_in + nt * 128, 1792};
        EpStoreF32 ep{p.proj0, 1792, mt * PBM, nt * 128};
        gemm_tile<PROJ_MT, GD4>(smem, 1024, al, bl, ep);
      }
      break;
    case 3:
      for (int it = bid; it < 128; it += nb) fnet_tok_item(p, smem, it);
      for (int it = (bid + nb - 128) % nb; it < 1536; it += nb) scan_item(p, smem, it, false);
      break;
    case 4:
      for (int it = bid; it < 576; it += nb) {
        if (it < 512) {
          const int b = it >> 8, r = it & 255, mt = r >> 4, nt = (r >> 3) & 1, ksl = r & 7;
          ADft al{mt * 128, 2048, 2047, 1.0f / 2048.0f, ksl * 512};
          BDirect bl{p.YT + (size_t)16 * 256 * 512 + (size_t)b * 256 * 4096 + (size_t)nt * 128 * 4096 + ksl * 512, 4096};
          EpDft ep{p.yfn, NCTX + b * 2048 + mt * 128, nt * 128, 0.02209708691207961f};
          gemm_tile<4, 1>(smem, 512, al, bl, ep);
        } else {
          const int r = it - 512, b = r >> 2, mt = (r >> 1) & 1, nt = r & 1;
          ADft al{mt * 128, 256, 255, 1.0f / 256.0f, 0};
          BDirect bl{p.YT + (size_t)b * 256 * 512 + (size_t)nt * 128 * 512, 512};
          EpDft ep{p.yfn, b * 256 + mt * 128, nt * 128, 0.0625f};
          gemm_tile<4, 1>(smem, 512, al, bl, ep);
        }
      }
      for (int it = (bid + nb - 64) % nb; it < 1536; it += nb) scan_item(p, smem, it, true);
      break;
    case 5:
    case 12: {
      const int l = ph == 5 ? 0 : 1;
      for (int it = bid; it < PNM * 8; it += nb) {
        const int mt = it % PNM, nt = it / PNM;
        BWeight bl{(l == 0 ? p.e_w_out : p.o_w_out) + nt * 128, 1024};
        const int vec = vec_of_token(mt * PBM);
        const int r0 = mt * PBM;
        const float* xin = l == 0 ? (r0 < NCTX ? p.x_prompt + (size_t)r0 * DM : p.x_sample + (size_t)(r0 - NCTX) * DM) : p.x2 + (size_t)r0 * DM;
        EpResidual ep{p.pre + (size_t)r0 * DM, xin, p.mod + ((size_t)l * 3 + vec) * 6144 + 2048, r0, nt * 128};
        if (l == 0) {
          AMixedFn al{p.mixed + (size_t)r0 * DM, p.yfn + (size_t)r0 * 256};
          gemm_tile<PROJ_MT, GD4>(smem, 1024, al, bl, ep);
        } else {
          ADirect al{p.mixed + (size_t)r0 * DM, DM};
          gemm_tile<PROJ_MT, GD4>(smem, 1024, al, bl, ep);
        }
      }
    } break;
    case 6:
    case 13:
      ln_router_phase(p, smem, ph == 6 ? 0 : 1);
      break;
    case 7:
    case 14:
      for (int it = bid; it < 32; it += nb) topk_item(p, smem, it);
      break;
    case 8:
    case 15: {
      const int l = ph == 8 ? 0 : 1;
      constexpr int NMT = 32 / MOE_MT;
      for (int it = vb; it < 16 * 32 * NMT; it += nb) {
        const int e = it / (32 * NMT), r = it % (32 * NMT), nt = r / NMT, mt = r % NMT;
        AGather al{p.tok, p.idx + e * 1024 + mt * (MOE_MT * 32), DM};
        const size_t wo = ((size_t)l * 16 + e) * 1024 * 2048 + nt * 64;
        BGateUp bl{p.w_gate + wo, (long long)((const char*)p.w_up - (const char*)p.w_gate), 2048};
        EpGateUp ep{(PROBE ? (bf16_t*)p.ye : p.hbuf) + (size_t)e * 1024 * 2048, mt * (MOE_MT * 32), nt * 64};
        gemm_tile<MOE_MT, MOE_D, PROBE>(smem, 1024, al, bl, ep);
      }
    } break;
    case 9:
    case 16: {
      const int l = ph == 9 ? 0 : 1;
      constexpr int NMT = 32 / MOE_MT;
      for (int it = vb; it < 16 * 8 * NMT; it += nb) {
        const int e = it / (8 * NMT), r = it % (8 * NMT), nt = r / NMT, mt = r % NMT;
        ADirect al{p.hbuf + ((size_t)e * 1024 + mt * (MOE_MT * 32)) * 2048, 2048};
        BWeight bl{p.w_down + ((size_t)l * 16 + e) * 2048 * 1024 + nt * 128, 1024};
        EpDown ep{p.ye + (size_t)e * 1024 * 1024, mt * (MOE_MT * 32), nt * 128};
        gemm_tile<MOE_MT, MOE_D>(smem, 2048, al, bl, ep);
      }
    } break;
    case 10:
    case 17:
      final_ln_phase(p, ph == 10 ? 0 : 1);
      break;
    case 11:
      for (int it = bid; it < PNM * 18; it += nb) {
        const int mt = it % PNM, nt = it / PNM;
        ADirect al{p.ubuf + (size_t)mt * PBM * DM, DM};
        BWeight bl{p.o_w_in + nt * 128, 2304};
        EpOddProj ep{OddPtrs{p.swaQ, p.swaK, p.swaVt, p.diffQ, p.diffK, p.diffVt, p.out}, mt * PBM, nt * 128};
        gemm_tile<PROJ_MT, GD4>(smem, 1024, al, bl, ep);
      }
      break;
    case 18:
      for (int it = bid; it < 512; it += nb) {
        if (it < 256) {
          const int h = (it & 7) * 32 + (it >> 3);
          attn_item<true>(p, smem, 16 + (h >> 7), (h >> 5) & 3, h & 31);
        }
        else { const int r = it - 256; attn_item<true>(p, smem, r >> 4, (r >> 2) & 3, r & 3); }
      }
      for (int it = nb - 1 - bid; it < 512; it += nb) {
        if (it < 256) attn_item<false>(p, smem, 16 + (it >> 7), (it >> 6) & 1, it & 63);
        else { const int r = it - 256; attn_item<false>(p, smem, r >> 4, (r >> 3) & 1, r & 7); }
      }
      break;
  }
}

#ifndef DUP_PROBE
#define DUP_PROBE false
#endif
#ifndef DUP_MASK
#define DUP_MASK 0u
#endif
#ifndef PHASE_MASK
#define PHASE_MASK 0x7ffffu
#endif
#define STEP(i, PH)                                              \
  if (((PHASE_MASK >> (i)) & 1u) && lo <= (i) && (i) < hi) {      \
    run_phase<PH>(p, smem);                                       \
    if (COOP && ((DUP_MASK >> (i)) & 1u)) { xcd_barrier(xb); run_phase<PH, DUP_PROBE>(p, smem); }   \
    if (COOP && (i) + 1 < hi) xcd_barrier(xb);                    \
  }

template <bool COOP>
__global__ void __launch_bounds__(256, 2) mega_kernel(Params p, int lo_, int hi_) {
  __shared__ __attribute__((aligned(16))) char smem[65536];
  const int lo = COOP ? 0 : lo_, hi = COOP ? NPHASE : hi_;
  __shared__ uint4 xb_words;
  XcdBarrier xb;
  if (COOP) {
    if (threadIdx.x == 0) xb_words = make_uint4(0u, 0u, 0u, 0u);
    __syncthreads();
    xb = xcd_barrier_post(p.bar, (volatile LAS unsigned*)&xb_words);
    if (hi_ == 12345) cg::this_grid().sync();
  }
  STEP(0, 0) STEP(1, 1) STEP(2, 2) STEP(3, 3) STEP(4, 4) STEP(5, 5) STEP(6, 6) STEP(7, 7) STEP(8, 8) STEP(9, 9)
  STEP(10, 10) STEP(11, 11) STEP(12, 18) STEP(13, 12) STEP(14, 13) STEP(15, 14) STEP(16, 15) STEP(17, 16) STEP(18, 17)
}

extern "C" void kernel_launch(void* const* d_in, const int* in_sizes, int n_in, void* d_out, int out_size,
                              void* d_ws, size_t ws_size, hipStream_t stream) {
  Params p;
  memset(&p, 0, sizeof(p));
  const float** pin = (const float**)&p;
  for (int i = 0; i < 32; ++i) pin[i] = (const float*)d_in[i];
  p.out = (float*)d_out;
  char* ws = (char*)d_ws;
  size_t off = 0;
  auto take = [&](size_t bytes) { char* r = ws + off; off += (bytes + 255) & ~(size_t)255; return r; };
  p.bar = (unsigned*)take(XCD_BAR_WORDS * 4);
  p.mod = (float*)take(2 * 3 * 6144 * 4);
  p.cnt = (unsigned*)take(1024);
  p.wcsT = (bf16_t*)take(32768 * 2);
  p.wrT = (float*)take(2 * 16384 * 4);
  p.lam = (float*)take(256);
  p.cswaK = (bf16_t*)take(65536 * 2);
  p.cswaVt = (bf16_t*)take(65536 * 2);
  p.cdiffK = (bf16_t*)take(262144 * 2);
  p.cdiffVt = (bf16_t*)take(262144 * 2);
  p.ubuf = (bf16_t*)take((size_t)NTOK * DM * 2);
  p.proj0 = (float*)take((size_t)NTOK * 1792 * 4);
  p.sumA = (float*)take(128 * 2 * 768 * 4);
  p.sumB = (float*)take(128 * 2 * 768 * 4);
  p.YT = (bf16_t*)take((size_t)4194304 * 2);
  p.yfn = (float*)take((size_t)NTOK * 256 * 4);
  p.mixed = (bf16_t*)take((size_t)NTOK * DM * 2);
  p.pre = (float*)take((size_t)NTOK * DM * 4);
  p.x1 = (float*)take((size_t)NTOK * DM * 4);
  p.tok = (bf16_t*)take((size_t)NTOK * DM * 2);
  p.aff = (float*)take((size_t)NTOK * 16 * 4);
  p.idx = (int*)take(16 * 1024 * 4);
  p.gsel = (float*)take(16 * 1024 * 4);
  p.hbuf = (bf16_t*)take((size_t)16 * 1024 * 2048 * 2);
  p.ffn = (float*)take(256);
  p.ye = (float*)take((size_t)16 * 1024 * 1024 * 4);
  p.tcount = (int*)take(NTOK * 4);
  p.tlist = (int*)take(NTOK * 16 * 4);
  p.x2 = (float*)take((size_t)NTOK * DM * 4);
  p.swaQ = (bf16_t*)take((size_t)NTOK * 512 * 2);
  p.swaK = (bf16_t*)take((size_t)2 * NTOK * 64 * 2);
  p.swaVt = (bf16_t*)take((size_t)2 * 64 * NTOK * 2);
  p.diffQ = (bf16_t*)take((size_t)NTOK * 512 * 2);
  p.diffK = (bf16_t*)take((size_t)4 * NTOK * 128 * 2);
  p.diffVt = (bf16_t*)take((size_t)4 * 128 * NTOK * 2);

  static int grid_blocks = 0;
  if (!grid_blocks) {
    int dev = 0, cus = 0, per_cu = 0;
    (void)hipGetDevice(&dev);
    (void)hipDeviceGetAttribute(&cus, hipDeviceAttributeMultiprocessorCount, dev);
    (void)hipOccupancyMaxActiveBlocksPerMultiprocessor(&per_cu, mega_kernel<MULTI_LAUNCH == 0>, 256, 0);
    if (per_cu > 2) per_cu = 2;
    if (per_cu < 1) per_cu = 1;
    grid_blocks = cus * per_cu;
    grid_blocks &= ~7;
  }
#if MULTI_LAUNCH
  for (int i = 0; i < NPHASE; ++i) {
    hipLaunchKernelGGL(mega_kernel<false>, dim3(grid_blocks), dim3(256), 0, stream, p, i, i + 1);
  }
#else
  (void)hipMemsetAsync(p.bar, 0, XCD_BAR_WORDS * 4 + 2 * 3 * 6144 * 4 + 1024, stream);
  int lo = 0, hi = NPHASE;
  void* args[] = {&p, &lo, &hi};
  hipError_t e = hipLaunchCooperativeKernel((void*)mega_kernel<true>, dim3(grid_blocks), dim3(256), args, 0, stream);
  if (e != hipSuccess) fprintf(stderr, "cooperative launch failed: %s (grid %d)\n", hipGetErrorString(e), grid_blocks);
#endif
}
```
